# Optimizing an MI355X kernel written in HIP

```python
import jax
import jax.numpy as jnp
from jax import lax
import numpy as np

D_MODEL = 1024
BATCH = 4
SEQ = 8192
DEPTH = 2

NORM_EPS = 1e-6
N_BRANCH = 3
N_ADA = 6

LRU_WIDTH = D_MODEL
LRU_BLOCKS = 16
LRU_BLOCK_DIM = LRU_WIDTH // LRU_BLOCKS
CONV_WIDTH = 4
LRU_C = 8.0

SB_HEADS = 8
SB_HEAD_DIM = D_MODEL // SB_HEADS
SB_WIDTH = SB_HEADS * SB_HEAD_DIM
Q_BLOCK = 128

RW_HEAD_DIM = 64
RW_HEADS = D_MODEL // RW_HEAD_DIM
RW_WIDTH = RW_HEADS * RW_HEAD_DIM
DECAY_LORA = 64
AAA_LORA = 64
GATE_LORA = 128
RW_IN = 3 * RW_WIDTH + DECAY_LORA + AAA_LORA + GATE_LORA
RW_GN_EPS = 1e-5 * RW_HEAD_DIM

N_IN = 2 * LRU_WIDTH + 3 * SB_WIDTH + RW_IN + N_BRANCH * D_MODEL

N_EXPERTS = 32
TOP_K = 4
D_FF = D_MODEL
SWIGLU_LIMIT = 7.0
SWIGLU_ALPHA = 1.702
EXPERT_BLOCK = 256

kernel_name = 'hybrid_rglru_stickbreak_rwkv7_moe_adaln'


def _split_at(t, widths):
    idx = [int(i) for i in np.cumsum(widths)[:-1]]
    return jnp.split(t, idx, axis=-1)


def rmsnorm(x, gain):
    xf = x.astype(jnp.float32)
    y = xf * lax.rsqrt(jnp.mean(xf * xf, axis=-1, keepdims=True) + NORM_EPS)
    return (y * gain.astype(jnp.float32)).astype(x.dtype)


def modulate(h, shift, scale):
    return h * (1 + scale[:, None, :]) + shift[:, None, :]


def shift_right(t, n):
    return jnp.pad(t, ((0, 0), (n, 0), (0, 0)))[:, : t.shape[1], :]


def _linear_combine(left, right):
    a_l, b_l = left
    a_r, b_r = right
    return a_l * a_r, a_r * b_l + b_r


def rglru_branch(x_in, x_gate, conv_w, conv_b, wa, ba, wx, bx, lam):
    bsz, seq, _ = x_in.shape
    xc = conv_b + sum(conv_w[k] * shift_right(x_in, k) for k in range(CONV_WIDTH))
    xb = xc.reshape(bsz, seq, LRU_BLOCKS, LRU_BLOCK_DIM)
    r = jax.nn.sigmoid(jnp.einsum('bsni,nij->bsnj', xb, wa).reshape(bsz, seq, LRU_WIDTH) + ba)
    i = jax.nn.sigmoid(jnp.einsum('bsni,nij->bsnj', xb, wx).reshape(bsz, seq, LRU_WIDTH) + bx)
    log_a = -LRU_C * r.astype(jnp.float32) * jax.nn.softplus(-lam.astype(jnp.float32))
    a = jnp.exp(log_a)
    b = jnp.sqrt(-jnp.expm1(2.0 * log_a)) * (i * xc).astype(jnp.float32)
    _, h = lax.associative_scan(_linear_combine, (a, b), axis=1)
    return jax.nn.gelu(x_gate) * h.astype(x_in.dtype)


def stick_breaking_attention(q, k, v):
    bsz, seq, n_heads, head_dim = q.shape
    n_blk = seq // Q_BLOCK
    f32 = jnp.float32
    qf = q.astype(f32) * (head_dim ** -0.5)
    kf = k.astype(f32)
    vf = v.astype(f32)
    qb = qf.reshape(bsz, n_blk, Q_BLOCK, n_heads, head_dim).transpose(1, 0, 3, 2, 4)
    kpos = jnp.arange(seq)

    def one_block(args):
        q_blk, blk = args
        qpos = blk * Q_BLOCK + jnp.arange(Q_BLOCK)
        z = jnp.einsum('bhqd,bkhd->bhqk', q_blk, kf)
        mask = kpos[None, :] < qpos[:, None]
        log_stay = jnp.where(mask, jax.nn.log_sigmoid(-z), 0.0)
        later = lax.cumsum(log_stay, axis=3, reverse=True) - log_stay
        attn = jnp.where(mask, jnp.exp(jax.nn.log_sigmoid(z) + later), 0.0)
        return jnp.einsum('bhqk,bkhd->bqhd', attn, vf)

    out = lax.map(one_block, (qb, jnp.arange(n_blk)))
    return out.transpose(1, 0, 2, 3, 4).reshape(bsz, seq, n_heads * head_dim).astype(q.dtype)


def rwkv7_branch(cols, mu, w0, w_up, a0, a_up, g_up, k_k, k_a, r_k, lnx_w, lnx_b):
    bsz, seq, _ = cols.shape
    f32 = jnp.float32
    cols = cols + mu * (shift_right(cols, 1) - cols)
    r, k, v, xw, xa, xg = _split_at(cols, (RW_WIDTH, RW_WIDTH, RW_WIDTH, DECAY_LORA, AAA_LORA, GATE_LORA))
    w_log = -jax.nn.softplus(-(w0 + jnp.tanh(xw) @ w_up).astype(f32)) - 0.5
    decay = jnp.exp(-jnp.exp(w_log))
    a = jax.nn.sigmoid(a0 + xa @ a_up)
    g = jax.nn.sigmoid(xg) @ g_up

    def heads(t):
        return t.reshape(bsz, seq, RW_HEADS, RW_HEAD_DIM).astype(f32)

    kk = heads(k * k_k)
    kk = kk / jnp.maximum(jnp.linalg.norm(kk, axis=-1, keepdims=True), 1e-12)
    k = k * (1 + (a - 1) * k_a)
    r_h, k_h, v_h, a_h, w_h = heads(r), heads(k), heads(v), heads(a), heads(decay)

    def step(state, inp):
        r_t, w_t, k_t, v_t, kk_t, a_t = inp
        sa = jnp.einsum('bhij,bhj->bhi', state, -kk_t)
        state = (state * w_t[:, :, None, :]
                 + sa[..., None] * (kk_t * a_t)[:, :, None, :]
                 + v_t[..., None] * k_t[:, :, None, :])
        return state, jnp.einsum('bhij,bhj->bhi', state, r_t)

    def time_major(t):
        return jnp.swapaxes(t, 0, 1)

    state0 = jnp.zeros((bsz, RW_HEADS, RW_HEAD_DIM, RW_HEAD_DIM), f32)
    _, y = lax.scan(step, state0, tuple(time_major(t) for t in (r_h, w_h, k_h, v_h, kk, a_h)))
    y = time_major(y)
    mean = jnp.mean(y, axis=-1, keepdims=True)
    var = jnp.mean(jnp.square(y - mean), axis=-1, keepdims=True)
    y = ((y - mean) * lax.rsqrt(var + RW_GN_EPS)).reshape(bsz, seq, RW_WIDTH) * lnx_w + lnx_b
    bonus = jnp.sum(r_h * k_h * r_k, axis=-1, keepdims=True) * v_h
    y = y + bonus.reshape(bsz, seq, RW_WIDTH)
    return (y * g).astype(cols.dtype)


def hybrid_mixer(h, w_in, conv_w, conv_b, lru_wa, lru_ba, lru_wx, lru_bx, lru_lambda,
                 rw_mu, rw_w0, rw_w_up, rw_a0, rw_a_up, rw_g_up, rw_k_k, rw_k_a, rw_r_k,
                 rw_lnx_w, rw_lnx_b, p_lru, p_sb, p_rwkv, w_out):
    bsz, seq, _ = h.shape
    cols = h @ w_in
    lru_x, lru_gate, q, k, v, rw_cols, gate_logits = _split_at(
        cols, (LRU_WIDTH, LRU_WIDTH, SB_WIDTH, SB_WIDTH, SB_WIDTH, RW_IN, N_BRANCH * D_MODEL))
    y_a = rglru_branch(lru_x, lru_gate, conv_w, conv_b, lru_wa, lru_ba, lru_wx, lru_bx, lru_lambda)

    def sb_heads(t):
        return t.reshape(bsz, seq, SB_HEADS, SB_HEAD_DIM)

    y_b = stick_breaking_attention(sb_heads(q), sb_heads(k), sb_heads(v))
    y_c = rwkv7_branch(rw_cols, rw_mu, rw_w0, rw_w_up, rw_a0, rw_a_up, rw_g_up,
                       rw_k_k, rw_k_a, rw_r_k, rw_lnx_w, rw_lnx_b)
    g_a, g_b, g_c = jnp.split(jax.nn.sigmoid(gate_logits), N_BRANCH, axis=-1)
    merged = g_a * (y_a @ p_lru) + g_b * (y_b @ p_sb) + g_c * (y_c @ p_rwkv)
    return merged @ w_out


def moe_ffn(h, w_router, b_router, w_gu, b_gu, w_down, b_down):
    bsz, seq, d = h.shape
    x = h.reshape(-1, d)
    n_tok = x.shape[0]
    logits = (x @ w_router + b_router).astype(jnp.float32)
    top_logit, top_idx = lax.top_k(logits, TOP_K)
    top_w = jax.nn.softmax(top_logit, axis=-1)
    n_assign = n_tok * TOP_K
    flat_e = top_idx.reshape(-1)
    order = jnp.argsort(flat_e)
    sorted_e = flat_e[order]
    counts = jnp.bincount(flat_e, length=N_EXPERTS)
    padded = (counts + EXPERT_BLOCK - 1) // EXPERT_BLOCK * EXPERT_BLOCK
    pad_end = jnp.cumsum(padded)
    pad_start = pad_end - padded
    start = jnp.cumsum(counts) - counts
    slot = pad_start[sorted_e] + jnp.arange(n_assign) - start[sorted_e]
    n_blocks = -(-n_assign // EXPERT_BLOCK) + N_EXPERTS
    n_slots = n_blocks * EXPERT_BLOCK
    slot_token = jnp.zeros((n_slots,), jnp.int32).at[slot].set((order // TOP_K).astype(jnp.int32))
    slot_weight = jnp.zeros((n_slots,), jnp.float32).at[slot].set(top_w.reshape(-1)[order])
    block_expert = jnp.minimum(
        jnp.searchsorted(pad_end, jnp.arange(n_blocks) * EXPERT_BLOCK, side='right'), N_EXPERTS - 1)

    def expert_block(args):
        tok, e = args
        xb = x[tok]
        gu = xb @ w_gu[e] + b_gu[e]
        gate, up = jnp.split(gu, 2, axis=-1)
        gate = jnp.minimum(gate, SWIGLU_LIMIT)
        up = jnp.clip(up, -SWIGLU_LIMIT, SWIGLU_LIMIT)
        act = (up + 1) * gate * jax.nn.sigmoid(SWIGLU_ALPHA * gate)
        return act @ w_down[e] + b_down[e]

    yb = lax.map(expert_block, (slot_token.reshape(n_blocks, EXPERT_BLOCK), block_expert))
    y = jnp.zeros_like(x).at[slot_token].add(yb.reshape(-1, d) * slot_weight[:, None].astype(x.dtype))
    return y.reshape(bsz, seq, d)


def setup_inputs(seed: int = 0) -> dict:
    key = jax.random.key(seed)
    ks = iter(jax.random.split(key, 48))
    L, D = DEPTH, D_MODEL

    def nrm(shape, scale):
        return jax.random.normal(next(ks), shape, jnp.float32) * scale

    def unif(shape, lo, hi):
        return jax.random.uniform(next(ks), shape, jnp.float32, lo, hi)

    u = unif((L, LRU_WIDTH), 0.9, 0.999) ** (1.0 / LRU_C)
    lru_lambda = jnp.log(u) - jnp.log1p(-u)
    return {
        'x': nrm((BATCH, SEQ, D), 1.0),
        'c': nrm((BATCH, D), 1.0),
        'w_ada': nrm((L, D, N_ADA * D), 0.02),
        'b_ada': nrm((L, N_ADA * D), 0.01),
        'norm_mix': 1.0 + nrm((L, D), 0.02),
        'norm_moe': 1.0 + nrm((L, D), 0.02),
        'norm_final': 1.0 + nrm((D,), 0.02),
        'w_in': nrm((L, D, N_IN), D ** -0.5),
        'conv_w': nrm((L, CONV_WIDTH, LRU_WIDTH), CONV_WIDTH ** -0.5),
        'conv_b': nrm((L, LRU_WIDTH), 0.01),
        'lru_wa': nrm((L, LRU_BLOCKS, LRU_BLOCK_DIM, LRU_BLOCK_DIM), LRU_BLOCK_DIM ** -0.5),
        'lru_ba': nrm((L, LRU_WIDTH), 0.01),
        'lru_wx': nrm((L, LRU_BLOCKS, LRU_BLOCK_DIM, LRU_BLOCK_DIM), LRU_BLOCK_DIM ** -0.5),
        'lru_bx': nrm((L, LRU_WIDTH), 0.01),
        'lru_lambda': lru_lambda,
        'rw_mu': unif((L, RW_IN), 0.0, 1.0),
        'rw_w0': unif((L, RW_WIDTH), -6.0, -1.0),
        'rw_w_up': nrm((L, DECAY_LORA, RW_WIDTH), 0.1),
        'rw_a0': nrm((L, RW_WIDTH), 0.1),
        'rw_a_up': nrm((L, AAA_LORA, RW_WIDTH), 0.1),
        'rw_g_up': nrm((L, GATE_LORA, RW_WIDTH), GATE_LORA ** -0.5),
        'rw_k_k': 0.85 + nrm((L, RW_WIDTH), 0.02),
        'rw_k_a': 1.0 + nrm((L, RW_WIDTH), 0.02),
        'rw_r_k': nrm((L, RW_HEADS, RW_HEAD_DIM), 0.1),
        'rw_lnx_w': 1.0 + nrm((L, RW_WIDTH), 0.02),
        'rw_lnx_b': nrm((L, RW_WIDTH), 0.01),
        'p_lru': nrm((L, LRU_WIDTH, D), LRU_WIDTH ** -0.5),
        'p_sb': nrm((L, SB_WIDTH, D), SB_WIDTH ** -0.5),
        'p_rwkv': nrm((L, RW_WIDTH, D), RW_WIDTH ** -0.5),
        'w_out': nrm((L, D, D), D ** -0.5),
        'w_router': nrm((L, D, N_EXPERTS), D ** -0.5),
        'b_router': nrm((L, N_EXPERTS), 0.01),
        'w_gu': nrm((L, N_EXPERTS, D, 2 * D_FF), D ** -0.5),
        'b_gu': nrm((L, N_EXPERTS, 2 * D_FF), 0.01),
        'w_down': nrm((L, N_EXPERTS, D_FF, D), D_FF ** -0.5),
        'b_down': nrm((L, N_EXPERTS, D), 0.01),
    }


def reference(x, c, w_ada, b_ada, norm_mix, norm_moe, norm_final, w_in, conv_w, conv_b,
              lru_wa, lru_ba, lru_wx, lru_bx, lru_lambda, rw_mu, rw_w0, rw_w_up, rw_a0, rw_a_up,
              rw_g_up, rw_k_k, rw_k_a, rw_r_k, rw_lnx_w, rw_lnx_b, p_lru, p_sb, p_rwkv, w_out,
              w_router, b_router, w_gu, b_gu, w_down, b_down):
    c_act = jax.nn.silu(c)
    for l in range(DEPTH):
        ada = c_act @ w_ada[l] + b_ada[l]
        sh_mix, sc_mix, g_mix, sh_ffn, sc_ffn, g_ffn = jnp.split(ada, N_ADA, axis=-1)
        h = modulate(rmsnorm(x, norm_mix[l]), sh_mix, sc_mix)
        mix = hybrid_mixer(h, w_in[l], conv_w[l], conv_b[l], lru_wa[l], lru_ba[l], lru_wx[l], lru_bx[l],
                           lru_lambda[l], rw_mu[l], rw_w0[l], rw_w_up[l], rw_a0[l], rw_a_up[l], rw_g_up[l],
                           rw_k_k[l], rw_k_a[l], rw_r_k[l], rw_lnx_w[l], rw_lnx_b[l],
                           p_lru[l], p_sb[l], p_rwkv[l], w_out[l])
        x = x + g_mix[:, None, :] * mix
        h = modulate(rmsnorm(x, norm_moe[l]), sh_ffn, sc_ffn)
        ffn = moe_ffn(h, w_router[l], b_router[l], w_gu[l], b_gu[l], w_down[l], b_down[l])
        x = x + g_ffn[:, None, :] * ffn
    return rmsnorm(x, norm_final)
```

```cpp
#include <hip/hip_runtime.h>
#include <cstdio>
#include <cstdint>
#include <type_traits>
#define LAS __attribute__((address_space(3)))
#ifndef PG8_WGM
#define PG8_WGM 4
#endif
namespace pg8 {
#define PG8_LAS __attribute__((address_space(3)))
typedef unsigned short bf16_t;
typedef short bf16x8 __attribute__((ext_vector_type(8)));
typedef float f32x4 __attribute__((ext_vector_type(4)));
typedef unsigned u32x4 __attribute__((ext_vector_type(4)));
constexpr int BM = 256, BK = 64, HALF = 128, HTB = HALF * BK * 2  , STAGE_BYTES = 8 * HTB, NXCD = 8, WGM = PG8_WGM;

__host__ __device__ __forceinline__ int lds_byte(int r, int c) { const int st = (r >> 4) * 2 + (c >> 5), rr = r & 15, cc = c & 31, ob = rr * 64 + cc * 2; return st * 1024 + (ob ^ (((ob >> 9) & 1) << 5)); }
__host__ __device__ __forceinline__ void stage_rc(int b, int& R, int& C) { const int st = b / 1024, sb = b % 1024, swz = sb ^ (((sb >> 9) & 1) << 5); R = (st >> 1) * 16 + swz / 64; C = (st & 1) * 32 + (swz % 64) / 2; }
__host__ __device__ __forceinline__ int perm32(int rho) { const int n = rho >> 4, i = rho & 15; return 8 * (i >> 2) + 4 * n + (i & 3); }

struct Unit { int pm, pn; };
struct Gemm { const bf16_t* A; const bf16_t* Bt; int M, N, K; };

template <class E, class = void> struct epi_perm2 { static constexpr bool v = false; };
template <class E> struct epi_perm2<E, std::void_t<decltype(E::PERM2)>> { static constexpr bool v = E::PERM2; };
struct StaticOrder {
    int nM, nN, nwg, G, c;
    __host__ __device__ void init(int M, int N, int G_, int c_) { nM = M / BM; nN = N / BM; nwg = nM * nN; G = G_; c = c_; }
    __host__ __device__ bool next(int i, Unit& u) const {
        const long L = (long)i * G + c; if (L >= nwg) return false;
        int wgid = (int)L; { const int q = nwg / NXCD, r = nwg % NXCD, xcd = wgid % NXCD, off = wgid / NXCD; wgid = (xcd < r ? xcd * (q + 1) : r * (q + 1) + (xcd - r) * q) + off; }
        const int nig = WGM * nN, gid = wgid / nig, fm = gid * WGM, gsz = (nM - fm) < WGM ? (nM - fm) : WGM;
        u.pm = fm + ((wgid % nig) % gsz); u.pn = (wgid % nig) / gsz; return true;
    }
    __device__ __forceinline__ void a_ready(const Unit&) const {}
    __device__ __forceinline__ void done(const Unit&) const {}
};

typedef float f32x2c __attribute__((ext_vector_type(2))); typedef __bf16 bf16x2c __attribute__((ext_vector_type(2)));
__device__ __forceinline__ unsigned cvt_pk_bf16(float lo, float hi) { const f32x2c v = {lo, hi}; const bf16x2c b = __builtin_convertvector(v, bf16x2c); return __builtin_bit_cast(unsigned, b); }
typedef float f32x2 __attribute__((ext_vector_type(2)));
typedef unsigned u32x2 __attribute__((ext_vector_type(2)));
__device__ __forceinline__ float bflo(unsigned w) { return __uint_as_float(w << 16); }
__device__ __forceinline__ float bfhi(unsigned w) { return __uint_as_float(w & 0xffff0000u); }
__device__ __forceinline__ float frcp(float x) { return __builtin_amdgcn_rcpf(x); }
__device__ __forceinline__ float sigm(float x) { return frcp(1.0f + __expf(-x)); }
__device__ __forceinline__ void unpack8(const u32x4 w, float (&f)[8]) { f[0] = bflo(w.x); f[1] = bfhi(w.x); f[2] = bflo(w.y); f[3] = bfhi(w.y); f[4] = bflo(w.z); f[5] = bfhi(w.z); f[6] = bflo(w.w); f[7] = bfhi(w.w); }
__device__ __forceinline__ u32x4 pack8(const float (&f)[8]) { u32x4 w; w.x = cvt_pk_bf16(f[0], f[1]); w.y = cvt_pk_bf16(f[2], f[3]); w.z = cvt_pk_bf16(f[4], f[5]); w.w = cvt_pk_bf16(f[6], f[7]); return w; }

#ifndef P2_MERGE
#define P2_MERGE 0
#endif
#ifndef P2_RESID
#define P2_RESID 0
#endif
struct EpiPlainBf16 {
    static constexpr bool PERM = true, AFTER_DRAIN = false;
    static constexpr bool PERM2 = true;
    static constexpr int WCS = 64, BJS = 32;
    bf16_t* O; int ldc;
    __device__ __forceinline__ void operator()(const f32x4 (&acc)[2][2][4][2], const Unit& u, int wr, int wc, int fr, int fq) const {
        const int row0 = u.pm * BM + wr * 64 + fr, col0 = u.pn * BM + wc * WCS + 8 * fq;
#ifdef PROBE_EPI2
        for (int rep_ = 0; rep_ < 2; ++rep_) { asm volatile("" ::: "memory");
#endif
#pragma unroll
        for (int ai = 0; ai < 2; ++ai)
#pragma unroll
            for (int m = 0; m < 4; ++m) { bf16_t* rowp = O + (size_t)(row0 + ai * HALF + m * 16) * ldc + col0;
#pragma unroll
                for (int bj = 0; bj < 2; ++bj) { const f32x4 v0 = acc[ai][bj][m][0], v1 = acc[ai][bj][m][1];
                    u32x4 w; w.x = cvt_pk_bf16(v0[0], v0[1]); w.y = cvt_pk_bf16(v0[2], v0[3]); w.z = cvt_pk_bf16(v1[0], v1[1]); w.w = cvt_pk_bf16(v1[2], v1[3]);
                    *(u32x4*)(rowp + bj * BJS) = w; } }
#ifdef PROBE_EPI2
        }
#endif
    }
};

struct EpiLora {
    static constexpr bool PERM = true, AFTER_DRAIN = false;
    bf16_t* om; bf16_t* bb; bf16_t* kp; const bf16_t* kk; bf16_t* g; const float* w0; const float* a0; const float* ka;
    __device__ __forceinline__ void operator()(const f32x4 (&acc)[2][2][4][2], const Unit& u, int wr, int wc, int fr, int fq) const {
        const int sec = u.pn >> 2, row0 = u.pm * BM + wr * 64 + fr, col0 = (u.pn & 3) * BM + wc * 32 + 8 * fq;
#pragma unroll
        for (int bj = 0; bj < 2; ++bj) {
            const int col = col0 + bj * HALF;
            if (sec == 0) {
                const f32x4 wa = *(const f32x4*)(w0 + col), wb = *(const f32x4*)(w0 + col + 4);
#pragma unroll
                for (int ai = 0; ai < 2; ++ai)
#pragma unroll
                    for (int m = 0; m < 4; ++m) { const size_t off = (size_t)(row0 + ai * HALF + m * 16) * 1024 + col; float o[8];
#pragma unroll
                        for (int j = 0; j < 8; ++j) { const float z = acc[ai][bj][m][j >> 2][j & 3] + (j < 4 ? wa[j & 3] : wb[j & 3]); o[j] = 0.6065306597f * sigm(z); }
                        *(u32x4*)(om + off) = pack8(o); }
            } else if (sec == 1) {
                const f32x4 aa = *(const f32x4*)(a0 + col), ab = *(const f32x4*)(a0 + col + 4), ca = *(const f32x4*)(ka + col), cb = *(const f32x4*)(ka + col + 4);
#pragma unroll
                for (int ai = 0; ai < 2; ++ai)
#pragma unroll
                    for (int m = 0; m < 4; ++m) { const size_t off = (size_t)(row0 + ai * HALF + m * 16) * 1024 + col;
                        float kkf[8], krf[8], ob[8], ok[8]; unpack8(*(const u32x4*)(kk + off), kkf); unpack8(*(const u32x4*)(kp + off), krf);
#pragma unroll
                        for (int j = 0; j < 8; ++j) { const float a = sigm(acc[ai][bj][m][j >> 2][j & 3] + (j < 4 ? aa[j & 3] : ab[j & 3])); ob[j] = kkf[j] * a; ok[j] = krf[j] * (1.0f + (a - 1.0f) * (j < 4 ? ca[j & 3] : cb[j & 3])); }
                        *(u32x4*)(bb + off) = pack8(ob); *(u32x4*)(kp + off) = pack8(ok);
                        asm volatile("" ::: "memory"); }
            } else {
#pragma unroll
                for (int ai = 0; ai < 2; ++ai)
#pragma unroll
                    for (int m = 0; m < 4; ++m) { const size_t off = (size_t)(row0 + ai * HALF + m * 16) * 1024 + col; float o[8];
#pragma unroll
                        for (int j = 0; j < 8; ++j) o[j] = acc[ai][bj][m][j >> 2][j & 3];
                        *(u32x4*)(g + off) = pack8(o); }
            }
        }
    }
};

template <int STEP> struct EpiMerge {
    static constexpr bool PERM = true, AFTER_DRAIN = false, PERM2 = (P2_MERGE != 0);
    static constexpr int WCS = PERM2 ? 64 : 32, BJS = PERM2 ? 32 : HALF;
    bf16_t* O; const bf16_t* cols;
    __device__ __forceinline__ void operator()(const f32x4 (&acc)[2][2][4][2], const Unit& u, int wr, int wc, int fr, int fq) const {
        const int row0 = u.pm * BM + wr * 64 + fr, col0 = u.pn * BM + wc * WCS + 8 * fq;
#pragma unroll
        for (int ai = 0; ai < 2; ++ai)
#pragma unroll
            for (int m = 0; m < 4; ++m) {
#pragma unroll
                for (int bj = 0; bj < 2; ++bj) {
                    const int row = row0 + ai * HALF + m * 16, col = col0 + bj * BJS;
                    float gl[8], o[8]; unpack8(*(const u32x4*)(cols + (size_t)row * 11520 + 8448 + STEP * 1024 + col), gl);
                    if (STEP > 0) unpack8(*(const u32x4*)(O + (size_t)row * 1024 + col), o);
#pragma unroll
                    for (int j = 0; j < 8; ++j) { const float t = sigm(gl[j]) * acc[ai][bj][m][j >> 2][j & 3]; o[j] = (STEP > 0) ? o[j] + t : t; }
                    *(u32x4*)(O + (size_t)row * 1024 + col) = pack8(o);
                } }
    }
};

template <bool XIN_BF16> struct EpiResid {
    static constexpr bool PERM = true, AFTER_DRAIN = false, PERM2 = (P2_RESID != 0);
    static constexpr int WCS = PERM2 ? 64 : 32, BJS = PERM2 ? 32 : HALF;
    const void* xin; bf16_t* xout; const float* gmix;
    __device__ __forceinline__ void operator()(const f32x4 (&acc)[2][2][4][2], const Unit& u, int wr, int wc, int fr, int fq) const {
        const int row0 = u.pm * BM + wr * 64 + fr, col0 = u.pn * BM + wc * WCS + 8 * fq;
#pragma unroll
        for (int ai = 0; ai < 2; ++ai)
#pragma unroll
            for (int m = 0; m < 4; ++m) { const int row = row0 + ai * HALF + m * 16, b = row >> 13;
#pragma unroll
                for (int bj = 0; bj < 2; ++bj) { const int col = col0 + bj * BJS; const size_t off = (size_t)row * 1024 + col;
                    float xi[8], o[8];
                    if (XIN_BF16) unpack8(*(const u32x4*)((const bf16_t*)xin + off), xi);
                    else { const f32x4 a0 = *(const f32x4*)((const float*)xin + off), a1 = *(const f32x4*)((const float*)xin + off + 4);
                        xi[0] = a0[0]; xi[1] = a0[1]; xi[2] = a0[2]; xi[3] = a0[3]; xi[4] = a1[0]; xi[5] = a1[1]; xi[6] = a1[2]; xi[7] = a1[3]; }
                    const f32x4 g0 = *(const f32x4*)(gmix + b * 6144 + col), g1 = *(const f32x4*)(gmix + b * 6144 + col + 4);
#pragma unroll
                    for (int j = 0; j < 8; ++j) o[j] = xi[j] + (j < 4 ? g0[j & 3] : g1[j & 3]) * acc[ai][bj][m][j >> 2][j & 3];
                    *(u32x4*)(xout + off) = pack8(o); }
                asm volatile("" ::: "memory"); }
    }
};

struct EpiSwiglu {
    static constexpr bool PERM = true, AFTER_DRAIN = false;
    bf16_t* act; const float* bgu;
    __device__ __forceinline__ void operator()(const f32x4 (&acc)[2][2][4][2], const Unit& u, int wr, int wc, int fr, int fq) const {
        const int e = u.pn >> 3, ct = u.pn & 7, row0 = u.pm * BM + wr * 64 + fr, cl = ct * 128 + wc * 32 + 8 * fq;
        const float* bg = bgu + e * 2048 + cl; const float* bu = bg + 1024;
        const f32x4 g0 = *(const f32x4*)bg, g1 = *(const f32x4*)(bg + 4), u0 = *(const f32x4*)bu, u1 = *(const f32x4*)(bu + 4);
#pragma unroll
        for (int ai = 0; ai < 2; ++ai)
#pragma unroll
            for (int m = 0; m < 4; ++m) { const int row = row0 + ai * HALF + m * 16; float o[8];
#pragma unroll
                for (int j = 0; j < 8; ++j) {
                    float gt = acc[ai][0][m][j >> 2][j & 3] + (j < 4 ? g0[j & 3] : g1[j & 3]); float up = acc[ai][1][m][j >> 2][j & 3] + (j < 4 ? u0[j & 3] : u1[j & 3]);
                    gt = fminf(gt, 7.0f); up = fminf(fmaxf(up, -7.0f), 7.0f);
                    o[j] = (up + 1.0f) * gt * sigm(1.702f * gt); }
                *(u32x4*)(act + (size_t)row * 1024 + cl) = pack8(o); }
    }
};

struct EpiDown {
    static constexpr bool PERM = true, AFTER_DRAIN = false;
    bf16_t* yb; const float* bd;
    __device__ __forceinline__ void operator()(const f32x4 (&acc)[2][2][4][2], const Unit& u, int wr, int wc, int fr, int fq) const {
        const int e = u.pn >> 2, ct = u.pn & 3, row0 = u.pm * BM + wr * 64 + fr, col0 = ct * BM + wc * 32 + 8 * fq;
#pragma unroll
        for (int bj = 0; bj < 2; ++bj) { const int col = col0 + bj * HALF; const f32x4 b0 = *(const f32x4*)(bd + e * 1024 + col), b1 = *(const f32x4*)(bd + e * 1024 + col + 4);
#pragma unroll
            for (int ai = 0; ai < 2; ++ai)
#pragma unroll
                for (int m = 0; m < 4; ++m) { const int row = row0 + ai * HALF + m * 16; float o[8];
#pragma unroll
                    for (int j = 0; j < 8; ++j) o[j] = acc[ai][bj][m][j >> 2][j & 3] + (j < 4 ? b0[j & 3] : b1[j & 3]);
                    *(u32x4*)(yb + (size_t)row * 1024 + col) = pack8(o); } }
    }
};

template <int NCT> struct ExpertOrder {
    int nblk, G, c; const PG8_LAS int* blk_exp; const PG8_LAS int* rowt;
    __device__ __forceinline__ static int unit_blk(int i, int G_, int c_, int& ct) {
#ifdef EXP_RECT48
        if (NCT == 8) { const int x = c_ & 7, qq = c_ >> 3; ct = qq & 7; return (G_ / NCT) * i + 4 * x + (qq >> 3); }
#endif
        const int x = c_ & 7, qq = c_ >> 3, nh = NCT / 4, bg = x / nh, ch = x % nh; ct = 4 * ch + (qq & 3); return (G_ / NCT) * i + 8 * bg + (qq >> 2); }
    __device__ __forceinline__ bool next(int i, Unit& u) const {
        int ct; const int blk = unit_blk(i, G, c, ct); if (blk >= nblk) return false;
        const int e = __builtin_amdgcn_readfirstlane(blk_exp[blk]);
        u.pm = blk; u.pn = e * NCT + ct; return true;
    }
    __device__ __forceinline__ void a_ready(const Unit&) const {}
    __device__ __forceinline__ void done(const Unit&) const {}
};
template <class Epi, class Sched, bool ALIGN_EPI = false, bool SP2 = false, bool GATHER = false>
__device__ __forceinline__ void gemm_phase(PG8_LAS unsigned char* lds, const Gemm g, const Sched& S, const Epi& E) {
    int tid = threadIdx.x; asm volatile("" : "+v"(tid)); tid &= 511;
    const int wid = __builtin_amdgcn_readfirstlane(tid >> 6), lane = tid & 63, wr = wid >> 2, wc = wid & 3, fr = lane & 15, fq = lane >> 4;
    int K = g.K; asm volatile("" : "+s"(K));
    const int nt = K / BK;
    unsigned voffA[2], voffB[2];
#pragma unroll
    for (int i = 0; i < 2; ++i) { int R, C; stage_rc(tid * 16 + i * 8192, R, C); const int Rb = epi_perm2<Epi>::v ? (64 * (R >> 5) + perm32(R & 31)) : Epi::PERM ? ((R & ~31) + perm32(R & 31)) : R;
        voffA[i] = (unsigned)(R * K + C) * 2u; voffB[i] = (unsigned)(Rb * K + C) * 2u; }
    static_assert(!GATHER || SP2, "GATHER is wired into the SP2 loop only");
    int gR[2], gC[2];
#pragma unroll
    for (int i = 0; i < 2; ++i) stage_rc(tid * 16 + i * 8192, gR[i], gC[i]);
    unsigned cv[2][2], nv[2][2];
#define PG8_GVOFF(dst, ui_) do { if constexpr (GATHER) { _Pragma("unroll") for (int h_ = 0; h_ < 2; ++h_) _Pragma("unroll") for (int i_ = 0; i_ < 2; ++i_) \
        dst[h_][i_] = (unsigned)(S.rowt[(ui_) * 256 + 128 * h_ + gR[i_]] * K + gC[i_]) * 2u; } } while (0)
    const size_t kstep = (size_t)(BK * 2);
    const size_t hstep = (size_t)HALF * K * 2;
    const size_t hstepB = epi_perm2<Epi>::v ? (size_t)32 * K * 2 : hstep;
    const size_t tstep = 2 * hstep;
    const unsigned ldsw = (unsigned)wid * 1024u;
    const int aoff = lds_byte(wr * 64 + fr, fq * 8), boff = lds_byte(wc * 32 + fr, fq * 8);
#define PG8_SA(b, h) (((b) * 2 + (h)) * HTB)
#define PG8_SB(b, h) ((4 + (b) * 2 + (h)) * HTB)
#define PG8_STAGE(bufoff, gbase, voff) do { _Pragma("unroll") for (int _i = 0; _i < 2; ++_i) \
        __builtin_amdgcn_global_load_lds((const unsigned*)((const char*)(gbase) + (voff)[_i]), (PG8_LAS unsigned*)(lds + (bufoff) + ldsw + _i * 8192), 16, 0, 0); } while (0)
#define PG8_LDA(dst, b, h) do { _Pragma("unroll") for (int m = 0; m < 4; ++m) _Pragma("unroll") for (int k = 0; k < 2; ++k) dst[m][k] = *(const PG8_LAS bf16x8*)(lds + PG8_SA(b, h) + aoff + m * 2048 + k * 1024); } while (0)
#define PG8_LDB(dst, b, h) do { _Pragma("unroll") for (int n = 0; n < 2; ++n) _Pragma("unroll") for (int k = 0; k < 2; ++k) dst[n][k] = *(const PG8_LAS bf16x8*)(lds + PG8_SB(b, h) + boff + n * 2048 + k * 1024); } while (0)
#define PG8_MMA(ai, bj, At, Bt) do { __builtin_amdgcn_s_setprio(1); _Pragma("unroll") for (int m = 0; m < 4; ++m) _Pragma("unroll") for (int n = 0; n < 2; ++n) _Pragma("unroll") for (int k = 0; k < 2; ++k) \
        acc[ai][bj][m][n] = __builtin_amdgcn_mfma_f32_16x16x32_bf16(Bt[n][k], At[m][k], acc[ai][bj][m][n], 0, 0, 0); __builtin_amdgcn_s_setprio(0); } while (0)
#define PG8_WAIT_V(n) asm volatile("s_waitcnt vmcnt(" #n ")" ::: "memory")
#define PG8_WAIT_L(n) asm volatile("s_waitcnt lgkmcnt(" #n ")" ::: "memory")
#define PG8_BAR __builtin_amdgcn_s_barrier()
#define PG8_SCHED __builtin_amdgcn_sched_barrier(0)
    Unit cur, nxt; int ui = 0;
    if (!S.next(0, cur)) return;
    f32x4 acc[2][2][4][2];
#pragma unroll
    for (int a = 0; a < 2; ++a)
#pragma unroll
        for (int b = 0; b < 2; ++b)
#pragma unroll
            for (int m = 0; m < 4; ++m)
#pragma unroll
                for (int n = 0; n < 2; ++n) acc[a][b][m][n] = (f32x4){0.f, 0.f, 0.f, 0.f};
    bf16x8 At[4][2], B0[2][2], B1[2][2];
    const char* cA = (const char*)g.A + (GATHER ? (size_t)0 : (size_t)cur.pm * tstep); const char* cB = (const char*)g.Bt + (size_t)cur.pn * tstep;
    PG8_GVOFF(cv, 0);
#define PG8_STAGE_A(bufoff, kptr, h_, usenext) do { if constexpr (GATHER) { unsigned vs_[2]; vs_[0] = (usenext) ? nv[h_][0] : cv[h_][0]; vs_[1] = (usenext) ? nv[h_][1] : cv[h_][1]; PG8_STAGE(bufoff, kptr, vs_); } else PG8_STAGE(bufoff, (kptr) + (h_) * hstep, voffA); } while (0)
    S.a_ready(cur);
    if constexpr (SP2) {
        PG8_STAGE(PG8_SB(0, 0), cB, voffB); PG8_STAGE(PG8_SB(0, 1), cB + hstepB, voffB); PG8_STAGE_A(PG8_SA(0, 0), cA, 0, false); PG8_STAGE_A(PG8_SA(0, 1), cA, 1, false);
        if (wr == 1) PG8_BAR;
        PG8_WAIT_V(2); PG8_BAR;
        PG8_STAGE(PG8_SB(1, 0), cB + kstep, voffB); PG8_STAGE_A(PG8_SA(1, 0), cA + kstep, 0, false); PG8_STAGE(PG8_SB(1, 1), cB + hstepB + kstep, voffB);
        PG8_WAIT_V(6); PG8_BAR;
    } else {
        PG8_STAGE(PG8_SB(0, 0), cB, voffB); PG8_STAGE(PG8_SA(0, 0), cA, voffA); PG8_STAGE(PG8_SB(0, 1), cB + hstepB, voffB); PG8_STAGE(PG8_SA(0, 1), cA + hstep, voffA);
        if (wr == 1) PG8_BAR;
        PG8_WAIT_V(4); PG8_BAR;
        PG8_STAGE(PG8_SB(1, 0), cB + kstep, voffB); PG8_STAGE(PG8_SA(1, 0), cA + kstep, voffA); PG8_STAGE(PG8_SB(1, 1), cB + hstepB + kstep, voffB);
        PG8_WAIT_V(6); PG8_BAR;
    }
    for (;;) {
        const bool has_next = S.next(ui + 1, nxt);
        const char* nA = (has_next && !GATHER) ? (const char*)g.A + (size_t)nxt.pm * tstep : cA;
        if constexpr (GATHER) { if (has_next) PG8_GVOFF(nv, ui + 1); else { _Pragma("unroll") for (int h_ = 0; h_ < 2; ++h_) _Pragma("unroll") for (int i_ = 0; i_ < 2; ++i_) nv[h_][i_] = cv[h_][i_]; } } const char* nB = has_next ? (const char*)g.Bt + (size_t)nxt.pn * tstep : cB;
        for (int t = 0; t < nt; t += 2) {
            const bool last = (t == nt - 2);
            const char* a1 = cA + (size_t)(t + 1) * kstep;
            const char* a2 = last ? nA : cA + (size_t)(t + 2) * kstep; const char* b2 = last ? nB : cB + (size_t)(t + 2) * kstep;
            const char* a3 = a2 + kstep; const char* b3 = b2 + kstep;
            if (last && has_next) S.a_ready(nxt);
            if constexpr (SP2) {
            PG8_LDB(B0, 0, 0); PG8_LDB(B1, 0, 1); PG8_SCHED; PG8_LDA(At, 0, 0); PG8_STAGE_A(PG8_SA(1, 1), a1, 1, false);
            PG8_WAIT_V(8); PG8_WAIT_L(0); PG8_BAR; PG8_MMA(0, 0, At, B0); PG8_MMA(0, 1, At, B1); PG8_BAR; PG8_SCHED;
            PG8_LDA(At, 0, 1); PG8_STAGE(PG8_SB(0, 0), b2, voffB); PG8_STAGE(PG8_SB(0, 1), b2 + hstepB, voffB); PG8_STAGE_A(PG8_SA(0, 0), a2, 0, last);
            PG8_WAIT_V(8); PG8_WAIT_L(0); PG8_BAR; PG8_MMA(1, 0, At, B0); PG8_MMA(1, 1, At, B1); PG8_BAR; PG8_SCHED;
            PG8_LDB(B0, 1, 0); PG8_LDB(B1, 1, 1); PG8_SCHED; PG8_LDA(At, 1, 0); PG8_STAGE_A(PG8_SA(0, 1), a2, 1, last);
            PG8_WAIT_V(8); PG8_WAIT_L(0); PG8_BAR; PG8_MMA(0, 0, At, B0); PG8_MMA(0, 1, At, B1); PG8_BAR; PG8_SCHED;
            PG8_LDA(At, 1, 1); PG8_STAGE(PG8_SB(1, 0), b3, voffB); PG8_STAGE(PG8_SB(1, 1), b3 + hstepB, voffB); PG8_STAGE_A(PG8_SA(1, 0), a3, 0, last);
            PG8_WAIT_V(8); PG8_WAIT_L(0); PG8_BAR; PG8_MMA(1, 0, At, B0); PG8_MMA(1, 1, At, B1); PG8_BAR; PG8_SCHED;
            } else {
            PG8_LDB(B0, 0, 0); PG8_SCHED; PG8_LDA(At, 0, 0); PG8_STAGE(PG8_SA(1, 1), a1 + hstep, voffA);
            PG8_WAIT_L(8); PG8_BAR; PG8_WAIT_L(0); PG8_MMA(0, 0, At, B0); PG8_BAR; PG8_SCHED;
            PG8_LDB(B1, 0, 1); PG8_STAGE(PG8_SB(0, 0), b2, voffB);
            PG8_BAR; PG8_WAIT_L(0); PG8_MMA(0, 1, At, B1); PG8_BAR;
            PG8_LDA(At, 0, 1); PG8_STAGE(PG8_SA(0, 0), a2, voffA);
            PG8_BAR; PG8_WAIT_L(0); PG8_MMA(1, 0, At, B0); PG8_BAR; PG8_SCHED;
            PG8_STAGE(PG8_SB(0, 1), b2 + hstepB, voffB);
            PG8_WAIT_V(6); PG8_BAR; PG8_MMA(1, 1, At, B1); PG8_BAR;
            PG8_LDB(B0, 1, 0); PG8_SCHED; PG8_LDA(At, 1, 0); PG8_STAGE(PG8_SA(0, 1), a2 + hstep, voffA);
            PG8_WAIT_L(8); PG8_BAR; PG8_WAIT_L(0); PG8_MMA(0, 0, At, B0); PG8_BAR; PG8_SCHED;
            PG8_LDB(B1, 1, 1); PG8_STAGE(PG8_SB(1, 0), b3, voffB);
            PG8_BAR; PG8_WAIT_L(0); PG8_MMA(0, 1, At, B1); PG8_BAR;
            PG8_LDA(At, 1, 1); PG8_STAGE(PG8_SA(1, 0), a3, voffA);
            PG8_BAR; PG8_WAIT_L(0); PG8_MMA(1, 0, At, B0); PG8_BAR; PG8_SCHED;
            PG8_STAGE(PG8_SB(1, 1), b3 + hstepB, voffB);
            PG8_WAIT_V(6); PG8_BAR; PG8_MMA(1, 1, At, B1); PG8_BAR;
            }
        }
        if constexpr (ALIGN_EPI) { if (wr == 0) PG8_BAR; }
        if constexpr (!Epi::AFTER_DRAIN) { E(acc, cur, wr, wc, fr, fq); S.done(cur); }
        if (!has_next) break;
#pragma unroll
        for (int a = 0; a < 2; ++a)
#pragma unroll
            for (int b = 0; b < 2; ++b)
#pragma unroll
                for (int m = 0; m < 4; ++m)
#pragma unroll
                    for (int n = 0; n < 2; ++n) acc[a][b][m][n] = (f32x4){0.f, 0.f, 0.f, 0.f};
        cur = nxt; cA = nA; cB = nB; ++ui;
        if constexpr (GATHER) { _Pragma("unroll") for (int h_ = 0; h_ < 2; ++h_) _Pragma("unroll") for (int i_ = 0; i_ < 2; ++i_) cv[h_][i_] = nv[h_][i_]; }
        if constexpr (ALIGN_EPI) { if (wr == 1) PG8_BAR; }
    }
    PG8_WAIT_V(0);
    if constexpr (!ALIGN_EPI) { if (wr == 0) PG8_BAR; }
    PG8_BAR;
    if constexpr (Epi::AFTER_DRAIN) { E.fused(acc, cur, wr, wc, fr, fq, lds, wid, lane); S.done(cur); }
#undef PG8_SA
#undef PG8_SB
#undef PG8_STAGE
#undef PG8_STAGE_A
#undef PG8_GVOFF
#undef PG8_LDA
#undef PG8_LDB
#undef PG8_MMA
#undef PG8_WAIT_V
#undef PG8_WAIT_L
#undef PG8_BAR
#undef PG8_SCHED
}
}
#define XB_TMO      128
#define XB_XCNT(j)  (256  + 64 * (j))
#define XB_XSUB(j)  (1280 + 64 * (j))
#define XB_XGEN(j)  (2304 + 64 * (j))
#define XB_TOP      3328
#define XB_TOPGEN   3392
#define XCD_BAR_WORDS 3456
#define XB_SPIN_CAP (1u << 18)

__device__ __forceinline__ unsigned xb_ld(unsigned* p)              { return __hip_atomic_load(p, __ATOMIC_RELAXED, __HIP_MEMORY_SCOPE_AGENT); }
__device__ __forceinline__ unsigned xb_add(unsigned* p, unsigned v) { return __hip_atomic_fetch_add(p, v, __ATOMIC_RELAXED, __HIP_MEMORY_SCOPE_AGENT); }
__device__ __forceinline__ unsigned xb_xcc_id() { return (unsigned)__builtin_amdgcn_s_getreg((3 << 11) | 20) & 0xFu; }
#define XB_SPIN(cond, bar) do { unsigned _sp = 0; while (cond) { __builtin_amdgcn_s_sleep(1); \
    if ((++_sp & 255u) == 0u) { if (xb_ld(&(bar)[XB_TMO])) break; if (_sp > XB_SPIN_CAP) { atomicAdd(&(bar)[XB_TMO], 1u); break; } } } } while (0)

struct XcdBarrier {
    unsigned* bar; unsigned x;
    volatile LAS unsigned* st;
};

__device__ __forceinline__ XcdBarrier xcd_barrier_post(unsigned* bar, volatile LAS unsigned* st) {
    XcdBarrier b; b.bar = bar; b.x = xb_xcc_id(); b.st = st;
    if (threadIdx.x == 0) (void)xb_add(&bar[XB_XCNT(b.x)], 1u);
    return b;
}
__device__ __forceinline__ void xcd_barrier_complete(unsigned* bar, unsigned x, unsigned& nloc, unsigned& nx) {
    const unsigned G = gridDim.x * gridDim.y * gridDim.z;
    unsigned sum, cnt, mine, sp = 0u;
    for (;;) {
        sum = 0u; cnt = 0u; mine = 0u;
#pragma unroll
        for (unsigned j = 0; j < 16; ++j) { const unsigned c = xb_ld(&bar[XB_XCNT(j)]); sum += c; cnt += (c > 0u) ? 1u : 0u; mine = (j == x) ? c : mine; }
        if (sum == G) break;
        __builtin_amdgcn_s_sleep(1);
        if ((++sp & 255u) == 0u) { if (xb_ld(&bar[XB_TMO])) break; if (sp > XB_SPIN_CAP) { atomicAdd(&bar[XB_TMO], 1u); break; } }
    }
    nloc = mine > 0u ? mine : 1u; nx = cnt > 0u ? cnt : 1u;
}

__device__ __forceinline__ void xcd_barrier(const XcdBarrier& b) {
    asm volatile("s_waitcnt vmcnt(0)" ::: "memory");
    __syncthreads();
    if (threadIdx.x == 0) {
        unsigned* bar = b.bar;
        __builtin_amdgcn_s_waitcnt(0);
        unsigned nloc = b.st[0], nx = b.st[1];
        if (nloc == 0u) { xcd_barrier_complete(bar, b.x, nloc, nx); b.st[0] = nloc; b.st[1] = nx; }
        const unsigned old = xb_add(&bar[XB_XSUB(b.x)], 1u);
        const unsigned gen = old / nloc;
        if (old + 1u == (gen + 1u) * nloc) {
            __builtin_amdgcn_fence(__ATOMIC_RELEASE, "agent");
            asm volatile("s_waitcnt vmcnt(0)" ::: "memory");
            const unsigned og = xb_add(&bar[XB_TOP], 1u);
            const unsigned tg = og / nx;
            if (og + 1u == (tg + 1u) * nx) xb_add(&bar[XB_TOPGEN], 1u);
            else XB_SPIN(xb_ld(&bar[XB_TOPGEN]) == tg, bar);
            __builtin_amdgcn_fence(__ATOMIC_ACQUIRE, "agent");
            xb_add(&bar[XB_XGEN(b.x)], 1u);
            asm volatile("s_waitcnt vmcnt(0)" ::: "memory");
        } else {
            XB_SPIN(xb_ld(&bar[XB_XGEN(b.x)]) == gen, bar);
            __builtin_amdgcn_fence(__ATOMIC_ACQUIRE, "agent");
            asm volatile("s_waitcnt vmcnt(0)" ::: "memory");
        }
    }
    __syncthreads();
}
constexpr int NB = 4, S = 8192, D = 1024, M = NB * S, NIN = 11520, NL = 2, NE = 32;
constexpr int C_LRUX = 0, C_LRUG = 1024, C_Q = 2048, C_K = 3072, C_V = 4096, C_RW = 5120, C_GATE = 8448;
constexpr int NSLOT_MAX = (M * 4 / 256 + NE) * 256;
constexpr size_t MiB = 1u << 20;
constexpr size_t WS_CTL = 0, CTL_ZERO_BYTES = 1 * MiB;
constexpr size_t WS_ADA = 1 * MiB;
constexpr size_t WS_SUMM = 2 * MiB;
constexpr size_t WS_TOPE = 4 * MiB, WS_TOPW = 4 * MiB + 512 * 1024, WS_TSLOT = 5 * MiB;
constexpr size_t WS_STOK = 10 * MiB;
constexpr size_t WS_TRAW = 5 * MiB + 512 * 1024;
constexpr size_t WS_CARRY = 9 * MiB;
constexpr size_t WS_WAT = 6 * MiB, WS_WXT = 6 * MiB + 128 * 1024, WS_LORAB = 7 * MiB;
constexpr size_t WS_WIN = 16 * MiB, WS_PT = 39 * MiB, WS_WOUT = 45 * MiB, WS_WGU = 48 * MiB, WS_WD = 176 * MiB;
constexpr size_t WS_X1 = 240 * MiB, WS_X2 = 368 * MiB, WS_H = 496 * MiB;
constexpr size_t WS_COLS = 560 * MiB;
constexpr size_t WS_KK = 1280 * MiB, WS_BB = 1344 * MiB, WS_KP = 1408 * MiB, WS_R = 1472 * MiB, WS_OM = 1536 * MiB, WS_V = 1600 * MiB, WS_G = 1664 * MiB;
constexpr size_t WS_YA = 1728 * MiB, WS_YB = 1792 * MiB, WS_YC = 1856 * MiB, WS_VT = 1920 * MiB, WS_AP = 1984 * MiB, WS_END = 2000 * MiB;
constexpr size_t WS_XG = 560 * MiB, WS_ACT = 832 * MiB, WS_YBUF = 1104 * MiB;
static_assert(WS_YBUF + (size_t)NSLOT_MAX * 1024 * 2 <= WS_G, "MoE overlay");
constexpr int CW_TMO = 0, CW_BAR = 4096, CW_CNT = 8192, CW_CUR = 8448, CW_CVT = 8704;
constexpr int LDS_BYTES = 163840, TAB_OFF = 131072, ROWT_OFF = TAB_OFF + 4096, MISC_OFF = LDS_BYTES - 256;
constexpr int N_PHASES = 28;
#ifndef MK_PER_PHASE
#define MK_PER_PHASE 0
#endif

#define DI __device__ __forceinline__
#define LDS_WAIT() asm volatile("s_waitcnt lgkmcnt(0)" ::: "memory")
typedef unsigned short bf16;
typedef unsigned u32x4 __attribute__((ext_vector_type(4)));
typedef unsigned u32x2 __attribute__((ext_vector_type(2)));
typedef float f32x4 __attribute__((ext_vector_type(4)));
typedef float f32x16 __attribute__((ext_vector_type(16)));
typedef short bf16x8 __attribute__((ext_vector_type(8)));
using pg8::bflo; using pg8::bfhi; using pg8::sigm; using pg8::frcp; using pg8::f32x2c;
DI unsigned cvtpk(float lo, float hi) { return pg8::cvt_pk_bf16(lo, hi); }
DI float bf2f(bf16 b) { return __uint_as_float(((unsigned)b) << 16); }
DI bf16 f2bf(float f) { return (bf16)(cvtpk(f, 0.f) & 0xffffu); }
DI f32x4 load4bf(const bf16* p) { const u32x2 w = *(const u32x2*)p; return (f32x4){bflo(w.x), bfhi(w.x), bflo(w.y), bfhi(w.y)}; }
DI void store4bf(bf16* p, f32x4 v) { u32x2 w; w.x = cvtpk(v.x, v.y); w.y = cvtpk(v.z, v.w); *(u32x2*)p = w; }
#define SHX(v, m) __builtin_bit_cast(float, __builtin_amdgcn_ds_bpermute(((lane) ^ (m)) << 2, __builtin_bit_cast(int, (float)(v))))
#define SHXI(v, m) __builtin_amdgcn_ds_bpermute(((lane) ^ (m)) << 2, (int)(v))
#define SHUP(v, d) __builtin_bit_cast(float, __builtin_amdgcn_ds_bpermute(((lane) - (d)) << 2, __builtin_bit_cast(int, (float)(v))))
#define SHLANE(v, src) __builtin_bit_cast(float, __builtin_amdgcn_ds_bpermute((src) << 2, __builtin_bit_cast(int, (float)(v))))
DI float wave_sum(float v, int lane) {
    (void)lane;
#define DPPF_(ctrl_, rm_, bc_) __builtin_bit_cast(float, __builtin_amdgcn_update_dpp(0, __builtin_bit_cast(int, v), ctrl_, rm_, 0xf, bc_))
    v += DPPF_(0x111, 0xf, true); v += DPPF_(0x112, 0xf, true); v += DPPF_(0x114, 0xf, true); v += DPPF_(0x118, 0xf, true); v += DPPF_(0x142, 0xa, false); v += DPPF_(0x143, 0xc, false);
#undef DPPF_
    return __builtin_bit_cast(float, __builtin_amdgcn_readlane(__builtin_bit_cast(int, v), 63));
}
DI float grp16_sum(float v, int lane) { v += SHX(v, 1); v += SHX(v, 2); v += SHX(v, 4); v += SHX(v, 8); return v; }
DI float fexp2(float x) { return __builtin_amdgcn_exp2f(x); }
DI float flog2(float x) { return __builtin_amdgcn_logf(x); }
#define MFMA32(a, b, c) __builtin_amdgcn_mfma_f32_32x32x16_bf16((a), (b), (c), 0, 0, 0)
#define MFMA16(a, b, c) __builtin_amdgcn_mfma_f32_16x16x32_bf16((a), (b), (c), 0, 0, 0)
DI u32x4 zero4() { unsigned z; asm volatile("v_mov_b32 %0, 0" : "=v"(z)); return (u32x4){z, z, z, z}; }
DI int crow(int reg, int h) { return (reg & 3) + 8 * (reg >> 2) + 4 * h; }

struct Args { const float* in[36]; float* out; unsigned char* ws; int ph_lo, ph_hi, li, pad; };
struct PA { const float* const* in; float* out; unsigned char* ws; };
enum { I_X = 0, I_C, I_WADA, I_BADA, I_NMIX, I_NMOE, I_NFIN, I_WIN, I_CONVW, I_CONVB, I_WA, I_BA, I_WX, I_BX, I_LAM, I_MU, I_W0, I_WUP, I_A0, I_AUP, I_GUP, I_KK, I_KA, I_RK,
       I_LNW, I_LNB, I_PLRU, I_PSB, I_PRW, I_WOUT, I_WR, I_BR, I_WGU, I_BGU, I_WDN, I_BDN };

DI void ph_ada(const PA& a, LAS unsigned char* lds, int tid, int lane, int gw, int NGW) {
    LAS float* ca = (LAS float*)lds;
    LAS float* part = (LAS float*)(lds + 16384);
    for (int i = tid; i < 4096; i += 512) { const float c = a.in[I_C][i]; ca[i] = c * sigm(c); }
    __syncthreads();
    float* ADA = (float*)(a.ws + WS_ADA); const int wave = tid >> 6;
    for (int u = blockIdx.x; u < NL * 96; u += gridDim.x) {
        const int l = u / 96, col = (u % 96) * 64 + lane;
        const float* w = a.in[I_WADA] + (size_t)l * 1024 * 6144 + col;
        float a0 = 0.f, a1 = 0.f, a2 = 0.f, a3 = 0.f;
#pragma unroll 16
        for (int k = wave * 128; k < wave * 128 + 128; ++k) { const float wv = w[(size_t)k * 6144]; a0 += ca[k] * wv; a1 += ca[1024 + k] * wv; a2 += ca[2048 + k] * wv; a3 += ca[3072 + k] * wv; }
        part[(wave * 4 + 0) * 64 + lane] = a0; part[(wave * 4 + 1) * 64 + lane] = a1; part[(wave * 4 + 2) * 64 + lane] = a2; part[(wave * 4 + 3) * 64 + lane] = a3;
        __syncthreads();
        if (wave < 4) { float sacc = 0.f;
#pragma unroll
            for (int q = 0; q < 8; ++q) sacc += part[(q * 4 + wave) * 64 + lane];
            ADA[(l * 4 + wave) * 6144 + col] = sacc + a.in[I_BADA][l * 6144 + col]; }
        __syncthreads();
    }
}

DI void tr_item(const float* __restrict__ W, int N, int k0, int n0, bf16* WT, int ldk, int drow0, int dk, LAS float* scr, int lane) {
#pragma unroll
    for (int i = 0; i < 8; ++i) { const int kk = 8 * i + (lane >> 3); const f32x4 v = *(const f32x4*)(W + (size_t)(k0 + kk) * N + n0 + 4 * (lane & 7));
        LAS float* s = scr + kk * 33 + 4 * (lane & 7); s[0] = v.x; s[1] = v.y; s[2] = v.z; s[3] = v.w; }
    LDS_WAIT();
    const int c = lane & 7;
#pragma unroll
    for (int j = 0; j < 4; ++j) { const int n = (lane >> 3) + 8 * j; const LAS float* s = scr + (8 * c) * 33 + n;
        u32x4 o; o.x = cvtpk(s[0 * 33], s[1 * 33]); o.y = cvtpk(s[2 * 33], s[3 * 33]); o.z = cvtpk(s[4 * 33], s[5 * 33]); o.w = cvtpk(s[6 * 33], s[7 * 33]);
        *(u32x4*)(WT + (size_t)(drow0 + n) * ldk + dk + 8 * c) = o; }
    LDS_WAIT();
}
constexpr int CVT_EXPERT_ITEMS = 32768 + 16384;
DI void convert_expert_item(const PA& a, int l, int it, LAS float* scr, int lane) {
    unsigned char* ws = a.ws; bf16* WguT = (bf16*)(ws + WS_WGU); bf16* WdT = (bf16*)(ws + WS_WD);
    if (it < 32768) { const int e = it / 1024, r2 = it % 1024, kb = r2 / 64, nb = r2 % 64, n0 = 32 * nb;
        const int drow = e * 2048 + (n0 < 1024 ? 256 * (n0 / 128) + (n0 % 128) : 256 * ((n0 - 1024) / 128) + 128 + ((n0 - 1024) % 128));
        tr_item(a.in[I_WGU] + ((size_t)l * NE + e) * 1024 * 2048, 2048, 64 * kb, n0, WguT, 1024, drow, 64 * kb, scr, lane); }
    else { const int r = it - 32768, e = r / 512, r2 = r % 512, kb = r2 / 32, nb = r2 % 32;
        tr_item(a.in[I_WDN] + ((size_t)l * NE + e) * 1024 * 1024, 1024, 64 * kb, 32 * nb, WdT, 1024, e * 1024 + 32 * nb, 64 * kb, scr, lane); }
}
DI void cvt_item_decode(const PA& a, int l, int it, const float*& src, int& N, int& k0, int& n0, bf16*& dst, int& drow) {
    unsigned char* ws = a.ws;
    if (it < 32768) { const int e = it / 1024, r2 = it % 1024, kb = r2 / 64, nb = r2 % 64; n0 = 32 * nb; k0 = 64 * kb; N = 2048;
        drow = e * 2048 + (n0 < 1024 ? 256 * (n0 / 128) + (n0 % 128) : 256 * ((n0 - 1024) / 128) + 128 + ((n0 - 1024) % 128));
        src = a.in[I_WGU] + ((size_t)l * NE + e) * 1024 * 2048; dst = (bf16*)(ws + WS_WGU); }
    else { const int r = it - 32768, e = r / 512, r2 = r % 512, kb = r2 / 32, nb = r2 % 32; n0 = 32 * nb; k0 = 64 * kb; N = 1024;
        drow = e * 1024 + n0; src = a.in[I_WDN] + ((size_t)l * NE + e) * 1024 * 1024; dst = (bf16*)(ws + WS_WD); }
}
DI void cvt_item_load(const PA& a, int l, int it, int lane, f32x4 (&v)[8]) {
    const float* src; int N, k0, n0, drow; bf16* dst; cvt_item_decode(a, l, it, src, N, k0, n0, dst, drow);
#pragma unroll
    for (int i = 0; i < 8; ++i) v[i] = *(const f32x4*)(src + (size_t)(k0 + 8 * i + (lane >> 3)) * N + n0 + 4 * (lane & 7));
}
DI void cvt_item_finish(const PA& a, int l, int it, int lane, const f32x4 (&v)[8], LAS float* scr) {
    const float* src; int N, k0, n0, drow; bf16* dst; cvt_item_decode(a, l, it, src, N, k0, n0, dst, drow);
#pragma unroll
    for (int i = 0; i < 8; ++i) { LAS float* s = scr + (8 * i + (lane >> 3)) * 33 + 4 * (lane & 7); s[0] = v[i].x; s[1] = v[i].y; s[2] = v[i].z; s[3] = v[i].w; }
    LDS_WAIT();
    const int c = lane & 7;
#pragma unroll
    for (int j = 0; j < 4; ++j) { const int n = (lane >> 3) + 8 * j; const LAS float* s = scr + (8 * c) * 33 + n;
        u32x4 o; o.x = cvtpk(s[0 * 33], s[1 * 33]); o.y = cvtpk(s[2 * 33], s[3 * 33]); o.z = cvtpk(s[4 * 33], s[5 * 33]); o.w = cvtpk(s[6 * 33], s[7 * 33]);
        *(u32x4*)(dst + (size_t)(drow + n) * 1024 + k0 + 8 * c) = o; }
    LDS_WAIT();
}
DI void convert_expert_queue(const PA& a, int l, LAS float* scr, int lane) {
    unsigned* ctr = (unsigned*)(a.ws + WS_CTL) + CW_CVT + 64 * l;
    for (;;) { unsigned it = 0; if (lane == 0) it = __hip_atomic_fetch_add(ctr, 16u, __ATOMIC_RELAXED, __HIP_MEMORY_SCOPE_AGENT);
        it = (unsigned)__builtin_amdgcn_readfirstlane((int)it); if (it >= (unsigned)CVT_EXPERT_ITEMS) break;
#pragma nounroll
        for (int q = 0; q < 16; ++q) convert_expert_item(a, l, (int)it + q, scr, lane); }
}
DI void ph_convert(const PA& a, int l, LAS unsigned char* lds, int tid, int lane, int wave, int gw, int NGW) {
    LAS float* scr = (LAS float*)(lds + wave * 16384);
    unsigned char* ws = a.ws;
    bf16* WinT = (bf16*)(ws + WS_WIN); bf16* PT = (bf16*)(ws + WS_PT); bf16* WoT = (bf16*)(ws + WS_WOUT); bf16* WguT = (bf16*)(ws + WS_WGU); bf16* WdT = (bf16*)(ws + WS_WD);
    bf16* WaT = (bf16*)(ws + WS_WAT); bf16* WxT = (bf16*)(ws + WS_WXT); bf16* LB = (bf16*)(ws + WS_LORAB);
    constexpr int I0 = 5760, I1 = I0 + 1536, I2 = I1 + 512, I3 = I2, I4 = I3, I5 = I4 + 32, I6 = I5 + 32, I7 = I6 + 32, I8 = I7 + 32, I9 = I8 + 64;
    for (int it = gw; it < I9; it += NGW) {
        if (it < I0) { const int kb = it / 360, nb = it % 360; tr_item(a.in[I_WIN] + (size_t)l * 1024 * NIN, NIN, 64 * kb, 32 * nb, WinT, 1024, 32 * nb, 64 * kb, scr, lane); }
        else if (it < I1) { const int r = it - I0, br = r / 512, r2 = r % 512, kb = r2 / 32, nb = r2 % 32;
            const float* src = (br == 0 ? a.in[I_PLRU] : br == 1 ? a.in[I_PSB] : a.in[I_PRW]) + (size_t)l * 1024 * 1024;
            tr_item(src, 1024, 64 * kb, 32 * nb, PT + (size_t)br * 1024 * 1024, 1024, 32 * nb, 64 * kb, scr, lane); }
        else if (it < I2) { const int r = it - I1, kb = r / 32, nb = r % 32; tr_item(a.in[I_WOUT] + (size_t)l * 1024 * 1024, 1024, 64 * kb, 32 * nb, WoT, 1024, 32 * nb, 64 * kb, scr, lane); }
        else if (it < I3) { const int r = it - I2, e = r / 1024, r2 = r % 1024, kb = r2 / 64, nb = r2 % 64, n0 = 32 * nb;
            const int drow = e * 2048 + (n0 < 1024 ? 256 * (n0 / 128) + (n0 % 128) : 256 * ((n0 - 1024) / 128) + 128 + ((n0 - 1024) % 128));
            tr_item(a.in[I_WGU] + ((size_t)l * NE + e) * 1024 * 2048, 2048, 64 * kb, n0, WguT, 1024, drow, 64 * kb, scr, lane); }
        else if (it < I4) { const int r = it - I3, e = r / 512, r2 = r % 512, kb = r2 / 32, nb = r2 % 32;
            tr_item(a.in[I_WDN] + ((size_t)l * NE + e) * 1024 * 1024, 1024, 64 * kb, 32 * nb, WdT, 1024, e * 1024 + 32 * nb, 64 * kb, scr, lane); }
        else if (it < I5) { const int r = it - I4, n = r / 2, nb = r % 2; tr_item(a.in[I_WA] + ((size_t)l * 16 + n) * 4096, 64, 0, 32 * nb, WaT, 64, n * 64 + 32 * nb, 0, scr, lane); }
        else if (it < I6) { const int r = it - I5, n = r / 2, nb = r % 2; tr_item(a.in[I_WX] + ((size_t)l * 16 + n) * 4096, 64, 0, 32 * nb, WxT, 64, n * 64 + 32 * nb, 0, scr, lane); }
        else if (it < I7) { const int nb = it - I6; tr_item(a.in[I_WUP] + (size_t)l * 64 * 1024, 1024, 0, 32 * nb, LB, 256, 32 * nb, 0, scr, lane); }
        else if (it < I8) { const int nb = it - I7; tr_item(a.in[I_AUP] + (size_t)l * 64 * 1024, 1024, 0, 32 * nb, LB, 256, 1024 + 32 * nb, 64, scr, lane); }
        else { const int r = it - I8, kb = r / 32, nb = r % 32; tr_item(a.in[I_GUP] + (size_t)l * 128 * 1024, 1024, 64 * kb, 32 * nb, LB, 256, 2048 + 32 * nb, 128 + 64 * kb, scr, lane); }
    }
    for (int idx = blockIdx.x * 512 + tid; idx < 3072 * 32; idx += NGW * 64) { const int row = idx >> 5, ch = idx & 31, sec = row >> 10;
        const bool nz = (sec == 0) ? (ch < 8) : (sec == 1) ? (ch >= 8 && ch < 16) : (ch >= 16);
        if (!nz) *(u32x4*)(LB + (size_t)row * 256 + 8 * ch) = zero4(); }
}

DI void ph_norm(const PA& a, int l, int mode, int lane, int gw) {
    unsigned char* ws = a.ws; const float* ADA = (const float*)(ws + WS_ADA);
    const bf16* x1 = (const bf16*)(ws + WS_X1); bf16* x2 = (bf16*)(ws + WS_X2); bf16* H = (bf16*)(ws + WS_H);
    const int* tslot = (const int*)(ws + WS_TSLOT); const float* topw = (const float*)(ws + WS_TOPW); const bf16* ybuf = (const bf16*)(ws + WS_YBUF);
    const float* gain = (mode == 2) ? a.in[I_NFIN] : a.in[I_NMIX] + l * 1024;
    f32x4 nx[4];
    if (mode == 0) {
#pragma unroll
        for (int j = 0; j < 4; ++j) nx[j] = *(const f32x4*)(a.in[I_X] + (size_t)(gw * 16) * 1024 + 4 * lane + 256 * j); }
    u32x2 yc[4][4], xc[4], yn[4][4], xn[4]; int sl[4]; float wc[4], wn[4];
#define NORM_ROWS(yb_, xr_, m_, s_) do { _Pragma("unroll") for (int j_ = 0; j_ < 4; ++j_) { const int col_ = 4 * lane + 256 * j_; xr_[j_] = *(const u32x2*)(x1 + (size_t)(m_) * 1024 + col_); \
        _Pragma("unroll") for (int q_ = 0; q_ < 4; ++q_) yb_[q_][j_] = *(const u32x2*)(ybuf + (size_t)s_[q_] * 1024 + col_); } } while (0)
    if (mode != 0) { const int mf = gw * 16;
#pragma unroll
        for (int q = 0; q < 4; ++q) { sl[q] = tslot[mf * 4 + q]; wc[q] = topw[mf * 4 + q]; }
        NORM_ROWS(yc, xc, mf, sl);
#pragma unroll
        for (int q = 0; q < 4; ++q) { sl[q] = tslot[(mf + 1) * 4 + q]; wn[q] = topw[(mf + 1) * 4 + q]; } }
#pragma nounroll
    for (int i = 0; i < 16; ++i) {
        const int m = gw * 16 + i, b = m >> 13;
        f32x4 v[4];
        if (mode == 0) {
#pragma unroll
            for (int j = 0; j < 4; ++j) v[j] = nx[j];
            const int mn = (i + 1 < 16) ? m + 1 : m;
#pragma unroll
            for (int j = 0; j < 4; ++j) nx[j] = *(const f32x4*)(a.in[I_X] + (size_t)mn * 1024 + 4 * lane + 256 * j);
        } else {
            const int lp = (mode == 2) ? NL - 1 : l - 1; const float* gffn = ADA + (lp * 4 + b) * 6144 + 5120;
            const int m1 = (i + 1 < 16) ? m + 1 : m, m2 = (i + 2 < 16) ? m + 2 : m;
            NORM_ROWS(yn, xn, m1, sl);
            float wnn[4];
#pragma unroll
            for (int q = 0; q < 4; ++q) { sl[q] = tslot[m2 * 4 + q]; wnn[q] = topw[m2 * 4 + q]; }
#pragma unroll
            for (int j = 0; j < 4; ++j) { const int col = 4 * lane + 256 * j;
#define UB(w_) ((f32x4){bflo(w_.x), bfhi(w_.x), bflo(w_.y), bfhi(w_.y)})
                f32x4 acc = wc[0] * UB(yc[0][j]); acc += wc[1] * UB(yc[1][j]); acc += wc[2] * UB(yc[2][j]); acc += wc[3] * UB(yc[3][j]);
                v[j] = UB(xc[j]) + *(const f32x4*)(gffn + col) * acc;
#undef UB
                if (mode == 1) store4bf(x2 + (size_t)m * 1024 + col, v[j]); }
#pragma unroll
            for (int q = 0; q < 4; ++q) { wc[q] = wn[q]; wn[q] = wnn[q]; }
        }
        float ss = 0.f;
#pragma unroll
        for (int j = 0; j < 4; ++j) ss += (v[j].x * v[j].x + v[j].y * v[j].y) + (v[j].z * v[j].z + v[j].w * v[j].w);
        const float rstd = 1.0f / sqrtf(wave_sum(ss, lane) * (1.0f / 1024.0f) + 1e-6f);
#pragma unroll
        for (int j = 0; j < 4; ++j) { const int col = 4 * lane + 256 * j; const f32x4 gn = *(const f32x4*)(gain + col);
            if (mode == 2) *(f32x4*)(a.out + (size_t)m * 1024 + col) = v[j] * rstd * gn;
            else { const f32x4 sh = *(const f32x4*)(ADA + (l * 4 + b) * 6144 + col), sc = *(const f32x4*)(ADA + (l * 4 + b) * 6144 + 1024 + col);
                store4bf(H + (size_t)m * 1024 + col, v[j] * rstd * gn * (1.0f + sc) + sh); } }
        if (mode != 0) {
#pragma unroll
            for (int j = 0; j < 4; ++j) { xc[j] = xn[j];
#pragma unroll
                for (int q = 0; q < 4; ++q) yc[q][j] = yn[q][j]; } }
    }
#undef NORM_ROWS
}

template <int K0, int K1> DI void rw_prep_load(const bf16* cols, int m, int lane, u32x2 (&d)[7]) {
    const bf16* base = cols + (size_t)m * NIN + C_RW + 4 * lane;
#pragma unroll
    for (int k = K0; k < K1; ++k) d[k - K0] = *(const u32x2*)(base + 256 * k);
}
template <int K0, int K1> DI void rw_prep_row(const PA& a, int l, int m, int lane, LAS u32x2* pl, const u32x2 (&cur)[7]) {
    unsigned char* ws = a.ws;
    bf16* KK = (bf16*)(ws + WS_KK); bf16* KP = (bf16*)(ws + WS_KP); bf16* R = (bf16*)(ws + WS_R); bf16* V = (bf16*)(ws + WS_V); bf16* AP = (bf16*)(ws + WS_AP);
    int zq; asm volatile("s_mov_b32 %0, 0" : "=s"(zq));
    const float* mu = a.in[I_MU] + l * 3328 + zq; const float* kkw = a.in[I_KK] + l * 1024 + zq;
#pragma unroll
    for (int k = K0; k < K1; ++k) { const u32x2 ck = cur[k - K0], pk = pl[64 * k]; pl[64 * k] = ck;
        const f32x4 xc = (f32x4){bflo(ck.x), bfhi(ck.x), bflo(ck.y), bfhi(ck.y)}, xp = (f32x4){bflo(pk.x), bfhi(pk.x), bflo(pk.y), bfhi(pk.y)};
        if (k < 12) { const int sec = k >> 2, col = 256 * (k & 3) + 4 * lane, cc = 1024 * sec + col;
            const f32x4 xs = xc + *(const f32x4*)(mu + cc) * (xp - xc);
            if (sec == 0) store4bf(R + (size_t)m * 1024 + col, xs);
            else if (sec == 2) store4bf(V + (size_t)m * 1024 + col, xs);
            else { store4bf(KP + (size_t)m * 1024 + col, xs);
                const f32x4 kv = xs * *(const f32x4*)(kkw + col);
                const float ssq = grp16_sum((kv.x * kv.x + kv.y * kv.y) + (kv.z * kv.z + kv.w * kv.w), lane);
                const float inv = 1.0f / fmaxf(sqrtf(ssq), 1e-12f);
                store4bf(KK + (size_t)m * 1024 + col, kv * inv); } }
        else { const int cc = 3072 + 4 * lane;
            const f32x4 xs = xc + *(const f32x4*)(mu + cc) * (xp - xc); f32x4 o;
            if (lane < 16) { o.x = 1.0f - 2.0f * frcp(__expf(2.0f * xs.x) + 1.0f); o.y = 1.0f - 2.0f * frcp(__expf(2.0f * xs.y) + 1.0f); o.z = 1.0f - 2.0f * frcp(__expf(2.0f * xs.z) + 1.0f); o.w = 1.0f - 2.0f * frcp(__expf(2.0f * xs.w) + 1.0f); }
            else if (lane < 32) o = xs;
            else { o.x = sigm(xs.x); o.y = sigm(xs.y); o.z = sigm(xs.z); o.w = sigm(xs.w); }
            store4bf(AP + (size_t)m * 256 + 4 * lane, o); } }
}
DI float gelu_tanh(float x) { const float u = 0.7978845608f * (x + 0.044715f * x * x * x); const float t = 1.0f - 2.0f * frcp(__expf(2.0f * u) + 1.0f); return 0.5f * x * (1.0f + t); }
DI void lru_phase(const PA& a, int l, LAS unsigned char* lds, int tid, int lane, int wave, int prep_m0 = -1) {
    LAS bf16* XS = (LAS bf16*)lds;
    LAS bf16* XA = (LAS bf16*)(lds + 16896);
    LAS float* AA = (LAS float*)(lds + 35328);
    LAS float* BBv = (LAS float*)(lds + 68096);
    LAS float* SEG = (LAS float*)(lds + 100864);
    unsigned char* ws = a.ws; const bf16* cols = (const bf16*)(ws + WS_COLS); float* summ = (float*)(ws + WS_SUMM); bf16* HL = (bf16*)(ws + WS_YA); bf16* PT = (bf16*)(ws + WS_H);
    const bf16* WaT = (const bf16*)(ws + WS_WAT); const bf16* WxT = (const bf16*)(ws + WS_WXT);
    const int n = blockIdx.x & 15, p0 = blockIdx.x >> 4;
    const int fr = lane & 15, fq = lane >> 4, c = tid & 63, seg = tid >> 6;
    bf16x8 wa[4][2], wx[4][2]; float ba[4], bx[4], spl[4];
#pragma unroll
    for (int ct = 0; ct < 4; ++ct) { const bf16* pa = WaT + (size_t)(n * 64 + 16 * ct + fr) * 64 + 8 * fq; const bf16* px = WxT + (size_t)(n * 64 + 16 * ct + fr) * 64 + 8 * fq;
        wa[ct][0] = *(const bf16x8*)pa; wa[ct][1] = *(const bf16x8*)(pa + 32); wx[ct][0] = *(const bf16x8*)px; wx[ct][1] = *(const bf16x8*)(px + 32);
        const int ch = 64 * n + 16 * ct + fr; ba[ct] = a.in[I_BA][l * 1024 + ch]; bx[ct] = a.in[I_BX][l * 1024 + ch]; const float lam = a.in[I_LAM][l * 1024 + ch];
        spl[ct] = fmaxf(-lam, 0.f) + __logf(1.0f + __expf(-fabsf(lam))); }
    const float* cw = a.in[I_CONVW] + (size_t)l * 4 * 1024 + 64 * n + c;
    const float w0 = cw[0], w1 = cw[1024], w2 = cw[2048], w3 = cw[3072], cb = a.in[I_CONVB][l * 1024 + 64 * n + c];
    u32x4 xin[3];
#define LRU_FETCH(p_) do { const int b_ = (p_) >> 6, tb_ = ((p_) & 63) * 128; _Pragma("unroll") for (int q_ = 0; q_ < 3; ++q_) { const int idx_ = tid + 512 * q_; const int row_ = idx_ >> 3, c8_ = idx_ & 7, tt_ = tb_ - 3 + row_; \
        xin[q_] = (u32x4){0u, 0u, 0u, 0u}; if (idx_ < 1048 && tt_ >= 0) xin[q_] = *(const u32x4*)(cols + ((size_t)b_ * S + tt_) * NIN + C_LRUX + 64 * n + 8 * c8_); } } while (0)
    LRU_FETCH(p0);
    u32x2 pcur[7]; LAS u32x2* pl = (LAS u32x2*)(lds + 104960 + wave * 6656) + lane;
    if (prep_m0 >= 0) { const bool hp = (prep_m0 & (S - 1)) != 0;
#pragma unroll
        for (int k = 0; k < 13; ++k) pl[64 * k] = hp ? *(const u32x2*)(cols + (size_t)(prep_m0 - 1) * NIN + C_RW + 4 * lane + 256 * k) : (u32x2){0u, 0u}; }
#pragma nounroll
    for (int i = 0; i < 16; ++i) {
        const int p = p0 + 16 * i, b = p >> 6, ck = p & 63, tb = ck * 128; const size_t rb = (size_t)b * S;
        if (prep_m0 >= 0) rw_prep_load<0, 7>(cols, prep_m0 + i, lane, pcur);
        float* sm = summ + ((size_t)((b * 16 + n) * 64) * 64) * 2;
#pragma unroll
        for (int q = 0; q < 3; ++q) { const int idx = tid + 512 * q; if (idx < 1048) *(LAS u32x4*)(XS + (idx >> 3) * 64 + 8 * (idx & 7)) = xin[q]; }
        __syncthreads();
        if (i + 1 < 16) LRU_FETCH(p + 16);
#pragma unroll 4
        for (int q = 0; q < 16; ++q) { const int tr = (tid >> 6) + 8 * q;
            const float xc = cb + w0 * bf2f(XS[(tr + 3) * 64 + c]) + w1 * bf2f(XS[(tr + 2) * 64 + c]) + w2 * bf2f(XS[(tr + 1) * 64 + c]) + w3 * bf2f(XS[tr * 64 + c]);
            XA[tr * 72 + c] = f2bf(xc); }
        __syncthreads();
        if (prep_m0 >= 0) rw_prep_row<0, 7>(a, l, prep_m0 + i, lane, pl, pcur);
        { const bf16x8 a0 = *(const LAS bf16x8*)(XA + (16 * wave + fr) * 72 + 8 * fq), a1 = *(const LAS bf16x8*)(XA + (16 * wave + fr) * 72 + 32 + 8 * fq);
#pragma unroll
          for (int ct = 0; ct < 4; ++ct) {
              f32x4 accR = (f32x4){0.f, 0.f, 0.f, 0.f}, accI = accR;
              accR = MFMA16(a0, wa[ct][0], accR); accR = MFMA16(a1, wa[ct][1], accR);
              accI = MFMA16(a0, wx[ct][0], accI); accI = MFMA16(a1, wx[ct][1], accI);
              const int cc = 16 * ct + fr;
#pragma unroll
              for (int r = 0; r < 4; ++r) { const int tr = 16 * wave + 4 * fq + r;
                  const float rr = sigm(accR[r] + ba[ct]), ii = sigm(accI[r] + bx[ct]), la = -8.0f * rr * spl[ct], av = __expf(la);
                  const float xc = bf2f(XA[tr * 72 + cc]);
                  AA[tr * 64 + cc] = av; BBv[tr * 64 + cc] = sqrtf(fmaxf(1.0f - __expf(2.0f * la), 0.f)) * ii * xc; } } }
        __syncthreads();
        if (prep_m0 >= 0) rw_prep_load<7, 13>(cols, prep_m0 + i, lane, pcur);
        { float Ap = 1.f, Hh = 0.f;
#pragma unroll 4
          for (int j = 0; j < 16; ++j) { const float av = AA[(16 * seg + j) * 64 + c], bv = BBv[(16 * seg + j) * 64 + c]; Hh = av * Hh + bv; Ap *= av; }
          SEG[(seg * 64 + c) * 2] = Ap; SEG[(seg * 64 + c) * 2 + 1] = Hh; }
        __syncthreads();
        {
            float Pp = 1.f, h = 0.f;
            for (int s = 0; s < seg; ++s) { const float sa = SEG[(s * 64 + c) * 2], sh = SEG[(s * 64 + c) * 2 + 1]; h = sa * h + sh; Pp *= sa; }
            const int ch = 64 * n + c;
#pragma unroll 4
            for (int j = 0; j < 16; ++j) { const int tr = 16 * seg + j; const float av = AA[tr * 64 + c]; h = av * h + BBv[tr * 64 + c]; Pp *= av;
                HL[(rb + tb + tr) * 1024 + ch] = f2bf(h); PT[(rb + tb + tr) * 1024 + ch] = f2bf(Pp); }
            if (seg == 7) { sm[((size_t)ck * 64 + c) * 2] = Pp; sm[((size_t)ck * 64 + c) * 2 + 1] = h; }
        }
        if (prep_m0 >= 0) rw_prep_row<7, 13>(a, l, prep_m0 + i, lane, pl, pcur);
        __syncthreads();
    }
#undef LRU_FETCH
}
DI void lru_carry(const PA& a, int tid) {
    unsigned char* ws = a.ws; const float* summ = (const float*)(ws + WS_SUMM); float* car = (float*)(ws + WS_CARRY);
    const int gid = blockIdx.x * 512 + tid; if (gid >= 4096) return;
    const int bn = gid >> 6, c = gid & 63; const float* sm = summ + ((size_t)bn * 64 * 64) * 2; float h = 0.f;
#pragma nounroll
    for (int q0 = 0; q0 < 64; q0 += 16) {
        float2 v[16];
#pragma unroll
        for (int j = 0; j < 16; ++j) v[j] = *(const float2*)(sm + ((size_t)(q0 + j) * 64 + c) * 2);
#pragma unroll
        for (int j = 0; j < 16; ++j) { car[((size_t)bn * 64 + q0 + j) * 64 + c] = h; h = v[j].x * h + v[j].y; } }
}
DI void lru_finish_row(const PA& a, int m, int lane) {
    unsigned char* ws = a.ws; const bf16* cols = (const bf16*)(ws + WS_COLS); bf16* YA = (bf16*)(ws + WS_YA); const bf16* PT = (const bf16*)(ws + WS_H); const float* car = (const float*)(ws + WS_CARRY);
    const int b = m >> 13, ck = (m & (S - 1)) >> 7;
#pragma unroll
    for (int j = 0; j < 4; ++j) { const int ch = 256 * j + 4 * lane; const size_t off = (size_t)m * 1024 + ch;
        const f32x4 hl = load4bf(YA + off), pt = load4bf(PT + off), gt = load4bf(cols + (size_t)m * NIN + C_LRUG + ch);
        const f32x4 cr = *(const f32x4*)(car + ((size_t)((b * 16 + (ch >> 6)) * 64 + ck)) * 64 + (ch & 63));
        const f32x4 h = hl + pt * cr;
        store4bf(YA + off, (f32x4){gelu_tanh(gt.x) * h.x, gelu_tanh(gt.y) * h.y, gelu_tanh(gt.z) * h.z, gelu_tanh(gt.w) * h.w}); }
}

struct LruFin { u32x2 hl[2], pt[2], gt[2]; f32x4 cr[2]; };
DI void lru_fin_load(const PA& a, int m, int jh, int lane, LruFin& r) {
    unsigned char* ws = a.ws; const bf16* cols = (const bf16*)(ws + WS_COLS); const bf16* YA = (const bf16*)(ws + WS_YA); const bf16* PT = (const bf16*)(ws + WS_H); const float* car = (const float*)(ws + WS_CARRY);
    const int b = m >> 13, ck = (m & (S - 1)) >> 7;
#pragma unroll
    for (int q = 0; q < 2; ++q) { const int ch = 256 * (2 * jh + q) + 4 * lane; const size_t off = (size_t)m * 1024 + ch;
        r.hl[q] = *(const u32x2*)(YA + off); r.pt[q] = *(const u32x2*)(PT + off); r.gt[q] = *(const u32x2*)(cols + (size_t)m * NIN + C_LRUG + ch);
        r.cr[q] = *(const f32x4*)(car + ((size_t)((b * 16 + (ch >> 6)) * 64 + ck)) * 64 + (ch & 63)); }
}
DI void lru_fin_store(const PA& a, int m, int jh, int lane, const LruFin& r) {
    bf16* YA = (bf16*)(a.ws + WS_YA);
#pragma unroll
    for (int q = 0; q < 2; ++q) { const int ch = 256 * (2 * jh + q) + 4 * lane; const size_t off = (size_t)m * 1024 + ch;
        const f32x4 hl = (f32x4){bflo(r.hl[q].x), bfhi(r.hl[q].x), bflo(r.hl[q].y), bfhi(r.hl[q].y)}, pt = (f32x4){bflo(r.pt[q].x), bfhi(r.pt[q].x), bflo(r.pt[q].y), bfhi(r.pt[q].y)};
        const f32x4 gt = (f32x4){bflo(r.gt[q].x), bfhi(r.gt[q].x), bflo(r.gt[q].y), bfhi(r.gt[q].y)};
        const f32x4 h = hl + pt * r.cr[q];
        store4bf(YA + off, (f32x4){gelu_tanh(gt.x) * h.x, gelu_tanh(gt.y) * h.y, gelu_tanh(gt.z) * h.z, gelu_tanh(gt.w) * h.w}); }
}

DI void vt_item(const bf16* cols, bf16* Vt, int item, LAS bf16* scr, int lane) {
    const int st = item & 255, hd = (item >> 8) & 7, b = item >> 11; const int s0 = st * 32;
#pragma unroll
    for (int i = 0; i < 8; ++i) { const int idx = i * 64 + lane, row = idx >> 4, c8 = idx & 15;
        const u32x4 v = *(const u32x4*)(cols + ((size_t)b * S + s0 + row) * NIN + C_V + hd * 128 + 8 * c8);
        LAS unsigned* d = (LAS unsigned*)(scr + row * 130 + 8 * c8); d[0] = v.x; d[1] = v.y; d[2] = v.z; d[3] = v.w; }
    LDS_WAIT();
#pragma unroll
    for (int i = 0; i < 8; ++i) { const int idx = i * 64 + lane, d = idx >> 2, q = idx & 3;
        unsigned w[4];
#pragma unroll
        for (int p = 0; p < 4; ++p) { const unsigned lo = scr[(8 * q + 2 * p) * 130 + d], hi = scr[(8 * q + 2 * p + 1) * 130 + d]; w[p] = lo | (hi << 16); }
        *(u32x4*)(Vt + (((size_t)(b * 8 + hd) * 256 + st) * 128 + d) * 32 + 8 * q) = (u32x4){w[0], w[1], w[2], w[3]}; }
    LDS_WAIT();
}

DI void rw_prep_wave(const PA& a, int l, int m0, int lane) {
    unsigned char* ws = a.ws; const bf16* cols = (const bf16*)(ws + WS_COLS);
    bf16* KK = (bf16*)(ws + WS_KK); bf16* KP = (bf16*)(ws + WS_KP); bf16* R = (bf16*)(ws + WS_R); bf16* V = (bf16*)(ws + WS_V); bf16* AP = (bf16*)(ws + WS_AP);
    const float* mu = a.in[I_MU] + l * 3328; const float* kkw = a.in[I_KK] + l * 1024;
    u32x2 prv[13], cur[13], nxt[13];
    const bf16* base = cols + (size_t)m0 * NIN + C_RW + 4 * lane;
    const bool has_prev0 = (m0 & (S - 1)) != 0;
#pragma unroll
    for (int k = 0; k < 13; ++k) { cur[k] = *(const u32x2*)(base + 256 * k); prv[k] = has_prev0 ? *(const u32x2*)(base - NIN + 256 * k) : (u32x2){0u, 0u}; }
#pragma nounroll
    for (int i = 0; i < 16; ++i) {
        const int m = m0 + i;
        if (i + 1 < 16) {
#pragma unroll
            for (int k = 0; k < 13; ++k) nxt[k] = *(const u32x2*)(base + (size_t)(i + 1) * NIN + 256 * k); }
#pragma unroll
        for (int k = 0; k < 12; ++k) { const int sec = k >> 2, col = 256 * (k & 3) + 4 * lane, cc = 1024 * sec + col;
            const f32x4 xc = (f32x4){bflo(cur[k].x), bfhi(cur[k].x), bflo(cur[k].y), bfhi(cur[k].y)}, xp = (f32x4){bflo(prv[k].x), bfhi(prv[k].x), bflo(prv[k].y), bfhi(prv[k].y)};
            const f32x4 xs = xc + *(const f32x4*)(mu + cc) * (xp - xc);
            if (sec == 0) store4bf(R + (size_t)m * 1024 + col, xs);
            else if (sec == 2) store4bf(V + (size_t)m * 1024 + col, xs);
            else { store4bf(KP + (size_t)m * 1024 + col, xs);
                const f32x4 kv = xs * *(const f32x4*)(kkw + col);
                const float ssq = grp16_sum((kv.x * kv.x + kv.y * kv.y) + (kv.z * kv.z + kv.w * kv.w), lane);
                const float inv = 1.0f / fmaxf(sqrtf(ssq), 1e-12f);
                store4bf(KK + (size_t)m * 1024 + col, kv * inv); } }
        { const int cc = 3072 + 4 * lane;
          const f32x4 xc = (f32x4){bflo(cur[12].x), bfhi(cur[12].x), bflo(cur[12].y), bfhi(cur[12].y)}, xp = (f32x4){bflo(prv[12].x), bfhi(prv[12].x), bflo(prv[12].y), bfhi(prv[12].y)};
          const f32x4 xs = xc + *(const f32x4*)(mu + cc) * (xp - xc); f32x4 o;
          if (lane < 16) { o.x = 1.0f - 2.0f * frcp(__expf(2.0f * xs.x) + 1.0f); o.y = 1.0f - 2.0f * frcp(__expf(2.0f * xs.y) + 1.0f); o.z = 1.0f - 2.0f * frcp(__expf(2.0f * xs.z) + 1.0f); o.w = 1.0f - 2.0f * frcp(__expf(2.0f * xs.w) + 1.0f); }
          else if (lane < 32) o = xs;
          else { o.x = sigm(xs.x); o.y = sigm(xs.y); o.z = sigm(xs.z); o.w = sigm(xs.w); }
          store4bf(AP + (size_t)m * 256 + 4 * lane, o); }
#pragma unroll
        for (int k = 0; k < 13; ++k) { prv[k] = cur[k]; cur[k] = nxt[k]; }
    }
}

#ifndef ATT_THR
#define ATT_THR 150.0f
#endif
constexpr int ATT_KP = 272, ATT_VP = 72, ATT_LDS = 32 * ATT_KP + 128 * ATT_VP;
DI void attn_strip(const bf16* cols, const bf16* Vt, bf16* YB, int item, int lane, LAS unsigned char* wl) {
    const int strip = item & 255, hd = (item >> 8) & 7, b = item >> 11;
    const int r = lane & 31, h = lane >> 5, t0 = strip * 32; const size_t rb = (size_t)b * S;
    LAS unsigned char* kb = wl; LAS unsigned char* vb = wl + 32 * ATT_KP;
    bf16x8 qf[8];
    {
        const bf16* qg = cols + (rb + t0 + (lane >> 4)) * NIN + C_Q + hd * 128 + 8 * (lane & 15);
        u32x4 tq[8];
#pragma unroll
        for (int i = 0; i < 8; ++i) tq[i] = *(const u32x4*)(qg + (size_t)(4 * i) * NIN);
#pragma unroll
        for (int i = 0; i < 8; ++i) *(LAS u32x4*)(kb + (4 * i + (lane >> 4)) * ATT_KP + 16 * (lane & 15)) = tq[i];
        LDS_WAIT();
#pragma unroll
        for (int kk = 0; kk < 8; ++kk) qf[kk] = *(const LAS bf16x8*)(kb + r * ATT_KP + 32 * kk + 16 * h);
        LDS_WAIT(); }
    f32x16 o[4];
#pragma unroll
    for (int dt = 0; dt < 4; ++dt)
#pragma unroll
        for (int i = 0; i < 16; ++i) o[dt][i] = 0.f;
    float R = 0.f;
    const float scl = 0.08838834764831845f * 1.4426950408889634f;
    const bf16* kg = cols + (rb + (lane >> 4)) * NIN + C_K + hd * 128 + 8 * (lane & 15);
    const bf16* vg = Vt + ((size_t)(b * 8 + hd) * 256 * 128 + (lane >> 2)) * 32 + 8 * (lane & 3);
    u32x4 tk[8], tv[8];
#define ATT_FETCH(s0_) do { _Pragma("unroll") for (int i_ = 0; i_ < 8; ++i_) { tk[i_] = *(const u32x4*)(kg + (size_t)((s0_) + 4 * i_) * NIN); tv[i_] = *(const u32x4*)(vg + (size_t)((s0_) >> 5) * 4096 + 512 * i_); } } while (0)
#define ATT_STASH() do { _Pragma("unroll") for (int i_ = 0; i_ < 8; ++i_) { *(LAS u32x4*)(kb + (4 * i_ + (lane >> 4)) * ATT_KP + 16 * (lane & 15)) = tk[i_]; \
            LAS unsigned char* vd_ = vb + (16 * i_ + (lane >> 2)) * ATT_VP + 16 * (lane & 3); *(LAS u32x2*)vd_ = (u32x2){tv[i_].x, tv[i_].y}; *(LAS u32x2*)(vd_ + 8) = (u32x2){tv[i_].z, tv[i_].w}; } } while (0)
    ATT_FETCH(t0); ATT_STASH();
    for (int s0 = t0; s0 >= 0; s0 -= 32) {
        if (s0 >= 32) ATT_FETCH(s0 - 32);
        f32x16 st;
#pragma unroll
        for (int i = 0; i < 16; ++i) st[i] = 0.f;
#pragma unroll
        for (int kk = 0; kk < 8; ++kk) st = MFMA32(*(const LAS bf16x8*)(kb + r * ATT_KP + 32 * kk + 16 * h), qf[kk], st);
        const bool diag = (s0 == t0);
        float zz[16], e[16];
#pragma unroll
        for (int i = 0; i < 16; ++i) { const float z = st[i] * scl; zz[i] = z; const bool valid = !diag || (crow(i, h) < r);
            const float sp = fmaxf(z, 0.f) + flog2(1.0f + fexp2(-fabsf(z)));
            e[i] = valid ? sp : 0.f; }
        float T[4], Tp[4];
#pragma unroll
        for (int g = 0; g < 4; ++g) { e[4 * g + 2] += e[4 * g + 3]; e[4 * g + 1] += e[4 * g + 2]; e[4 * g] += e[4 * g + 1]; T[g] = e[4 * g]; Tp[g] = SHX(T[g], 32); }
        const float G0 = T[0] + Tp[0], G1 = T[1] + Tp[1], G2 = T[2] + Tp[2], G3 = T[3] + Tp[3];
        float off[4]; off[3] = R; off[2] = R + G3; off[1] = off[2] + G2; off[0] = off[1] + G1;
        const float total = (off[0] - R) + G0;
#pragma unroll
        for (int g = 0; g < 4; ++g) if (h == 0) off[g] += Tp[g];
        float p[16];
#pragma unroll
        for (int i = 0; i < 16; ++i) { const bool valid = !diag || (crow(i, h) < r); const float w = fexp2(zz[i] - (e[i] + off[i >> 2])); p[i] = valid ? w : 0.f; }
        R += total;
        bf16x8 pa[2];
#pragma unroll
        for (int s = 0; s < 2; ++s) { u32x4 w; w.x = cvtpk(p[8 * s], p[8 * s + 1]); w.y = cvtpk(p[8 * s + 2], p[8 * s + 3]); w.z = cvtpk(p[8 * s + 4], p[8 * s + 5]); w.w = cvtpk(p[8 * s + 6], p[8 * s + 7]); pa[s] = __builtin_bit_cast(bf16x8, w); }
#pragma unroll
        for (int dt = 0; dt < 4; ++dt)
#pragma unroll
            for (int s = 0; s < 2; ++s) { const LAS unsigned char* vp = vb + (32 * dt + r) * ATT_VP + 32 * s + 8 * h;
                const u32x2 lo = *(const LAS u32x2*)vp, hi = *(const LAS u32x2*)(vp + 16);
                o[dt] = MFMA32(__builtin_bit_cast(bf16x8, (u32x4){lo.x, lo.y, hi.x, hi.y}), pa[s], o[dt]); }
        if (__all(R >= ATT_THR)) break;
        if (s0 >= 32) ATT_STASH();
    }
#undef ATT_FETCH
#undef ATT_STASH
#pragma unroll
    for (int dt = 0; dt < 4; ++dt)
#pragma unroll
        for (int g = 0; g < 4; ++g) { u32x2 w; w.x = cvtpk(o[dt][4 * g], o[dt][4 * g + 1]); w.y = cvtpk(o[dt][4 * g + 2], o[dt][4 * g + 3]); *(LAS u32x2*)(kb + r * ATT_KP + 2 * (32 * dt + 8 * g + 4 * h)) = w; }
    LDS_WAIT();
    { bf16* yg = YB + (rb + t0 + (lane >> 4)) * 1024 + hd * 128 + 8 * (lane & 15);
#pragma unroll
      for (int i = 0; i < 8; ++i) *(u32x4*)(yg + (size_t)(4 * i) * 1024) = *(const LAS u32x4*)(kb + (4 * i + (lane >> 4)) * ATT_KP + 16 * (lane & 15)); }
    LDS_WAIT();
}

constexpr int RWP = 72;
#define RWB(k) ((LAS bf16*)(lds + (k) * 9216))
DI f32x16 rw_tile(const LAS bf16* A, const LAS bf16* Bt, int tm, int tn, int r, int h, f32x16 acc) {
    const LAS bf16* ap = A + (32 * tm + r) * RWP + 8 * h; const LAS bf16* bp = Bt + (32 * tn + r) * RWP + 8 * h;
#pragma unroll
    for (int ks = 0; ks < 4; ++ks) acc = MFMA32(*(const LAS bf16x8*)(ap + 16 * ks), *(const LAS bf16x8*)(bp + 16 * ks), acc);
    return acc;
}
DI void rw_store_rm(LAS bf16* D, int tm, int tn, int r, int h, const f32x16& x) {
#pragma unroll
    for (int i = 0; i < 16; ++i) D[(32 * tm + crow(i, h)) * RWP + 32 * tn + r] = f2bf(x[i]);
}
DI void rw_store_tr(LAS bf16* D, int tm, int tn, int r, int h, const f32x16& x) {
#pragma unroll
    for (int g = 0; g < 4; ++g) { u32x2 w; w.x = cvtpk(x[4 * g], x[4 * g + 1]); w.y = cvtpk(x[4 * g + 2], x[4 * g + 3]); *(LAS u32x2*)(D + (32 * tn + r) * RWP + 32 * tm + 8 * g + 4 * h) = w; }
}
DI f32x16 f16zero() { f32x16 z;
#pragma unroll
    for (int i = 0; i < 16; ++i) z[i] = 0.f;
    return z; }

DI void rw1_load(const PA& a, int bh, int ck, int lane, int wave, u32x4 (&d)[6]) {
    unsigned char* ws = a.ws; const int b = bh >> 4, hd = bh & 15; const int tid_ = wave * 64 + lane;
    const size_t go = ((size_t)b * S + (size_t)ck * 64 + (tid_ >> 3)) * 1024 + hd * 64 + 8 * (tid_ & 7);
    d[0] = *(const u32x4*)((const bf16*)(ws + WS_KK) + go); d[1] = *(const u32x4*)((const bf16*)(ws + WS_BB) + go); d[2] = *(const u32x4*)((const bf16*)(ws + WS_KP) + go);
    d[3] = *(const u32x4*)((const bf16*)(ws + WS_R) + go); d[4] = *(const u32x4*)((const bf16*)(ws + WS_V) + go); d[5] = *(const u32x4*)((const bf16*)(ws + WS_OM) + go);
}
DI void rw1_unit(const PA& a, int l, int bh, int ck, LAS unsigned char* lds, int tid, int lane, int wave, const u32x4 (&in)[6], bool has_next, int nbh, int nck, u32x4 (&nx)[6], int cvt_it, int lru_m = -1, int lru_jh = 0, bool dummy = false) {
    LruFin lfr; if (lru_m >= 0) lru_fin_load(a, lru_m, lru_jh, lane, lfr);
    f32x4 cvr[8]; if (cvt_it >= 0) cvt_item_load(a, l, cvt_it, lane, cvr);
    unsigned char* ws = a.ws;
    bf16* KK = (bf16*)(ws + WS_KK); bf16* BBg = (bf16*)(ws + WS_BB); bf16* KP = (bf16*)(ws + WS_KP); bf16* Rg = (bf16*)(ws + WS_R); bf16* EW = (bf16*)(ws + WS_OM); const bf16* Vg = (const bf16*)(ws + WS_V);
    LAS float* RKP = (LAS float*)(lds + 16 * 9216);
    LAS float* GC = (LAS float*)(lds + 16 * 9216 + 2048);
    const int b = bh >> 4, hd = bh & 15, col0 = hd * 64; const size_t tok0 = (size_t)b * S + (size_t)ck * 64;
    const int r = lane & 31, h = lane >> 5;
    float bv[8];
    {
        const int t = lane, j0 = 8 * wave; const size_t go = (tok0 + t) * 1024 + col0 + j0;
        float kkf[8], bbf[8], kpf[8], rf[8], vf[8], ewf[8];
#pragma unroll
        for (int q = 0; q < 6; ++q) *(LAS u32x4*)(RWB(8 + q) + (tid >> 3) * RWP + 8 * (tid & 7)) = in[q];
        __syncthreads();
        pg8::unpack8(*(const LAS u32x4*)(RWB(8) + t * RWP + j0), kkf); pg8::unpack8(*(const LAS u32x4*)(RWB(9) + t * RWP + j0), bbf); pg8::unpack8(*(const LAS u32x4*)(RWB(10) + t * RWP + j0), kpf);
        pg8::unpack8(*(const LAS u32x4*)(RWB(11) + t * RWP + j0), rf); pg8::unpack8(*(const LAS u32x4*)(RWB(12) + t * RWP + j0), vf); pg8::unpack8(*(const LAS u32x4*)(RWB(13) + t * RWP + j0), ewf); (void)go;
        const float* rkw = a.in[I_RK] + l * 1024 + col0 + j0;
        float cl[8], pr = 0.f;
#pragma unroll
        for (int q = 0; q < 8; ++q) { cl[q] = -ewf[q]; pr += rf[q] * kpf[q] * rkw[q]; }
#pragma unroll
        for (int d = 1; d < 64; d <<= 1) {
#pragma unroll
            for (int q = 0; q < 8; ++q) { const float up = SHUP(cl[q], d); cl[q] += (lane >= d) ? up : 0.f; } }
        float At[8], Bt[8], Kt[8], Rt[8], Bp[8], Kp[8];
#pragma unroll
        for (int q = 0; q < 8; ++q) { const float clC = SHLANE(cl[q], 63);
            const float e1 = __expf(cl[q] + ewf[q]), e2 = __expf(-cl[q]), e3 = __expf(cl[q]), e4 = __expf(clC - cl[q]);
            At[q] = -kkf[q] * e1; Bt[q] = bbf[q] * e2; Kt[q] = kpf[q] * e2; Rt[q] = rf[q] * e3; Bp[q] = bbf[q] * e4; Kp[q] = kpf[q] * e4;
            if (lane == 63) GC[j0 + q] = e3; }
        *(LAS u32x4*)(RWB(0) + t * RWP + j0) = pg8::pack8(At); *(LAS u32x4*)(RWB(1) + t * RWP + j0) = pg8::pack8(Bt);
        *(LAS u32x4*)(RWB(2) + t * RWP + j0) = pg8::pack8(Kt); *(LAS u32x4*)(RWB(3) + t * RWP + j0) = pg8::pack8(Rt);
#pragma unroll
        for (int q = 0; q < 8; ++q) { RWB(4)[(j0 + q) * RWP + t] = f2bf(At[q]); RWB(5)[(j0 + q) * RWP + t] = f2bf(Bp[q]); RWB(6)[(j0 + q) * RWP + t] = f2bf(Kp[q]); RWB(7)[(j0 + q) * RWP + t] = f2bf(vf[q]); bv[q] = vf[q]; }
        RKP[wave * 64 + t] = pr;
    }
    __syncthreads();
    if (has_next) rw1_load(a, nbh, nck, lane, wave, nx);
    {
        const int t = lane; float rk = 0.f;
#pragma unroll
        for (int w = 0; w < 8; ++w) rk += RKP[w * 64 + t];
#pragma unroll
        for (int q = 0; q < 8; ++q) bv[q] *= rk;
        *(LAS u32x4*)(RWB(15) + t * RWP + 8 * wave) = pg8::pack8(bv);
    }
    {
        const int mat = wave >> 1, tm = wave & 1;
        const LAS bf16* Aop = (mat < 2) ? RWB(0) : RWB(3); const LAS bf16* Bop = (mat & 1) ? RWB(2) : RWB(1);
#pragma unroll
        for (int tn = 0; tn < 2; ++tn) {
            f32x16 x = rw_tile(Aop, Bop, tm, tn, r, h, f16zero());
#pragma unroll
            for (int i = 0; i < 16; ++i) { const int m = 32 * tm + crow(i, h), n = 32 * tn + r; const bool keep = (mat < 2) ? (m > n) : (m >= n); x[i] = keep ? x[i] : 0.f; }
            if (mat == 0) { rw_store_rm(RWB(11), tm, tn, r, h, x); rw_store_tr(RWB(12), tm, tn, r, h, x);
#pragma unroll
                for (int i = 0; i < 16; ++i) if (32 * tm + crow(i, h) == 32 * tn + r) x[i] += 1.0f;
                rw_store_rm(RWB(13), tm, tn, r, h, x); }
            else rw_store_rm(mat == 1 ? RWB(8) : mat == 2 ? RWB(9) : RWB(10), tm, tn, r, h, x);
        }
    }
    __syncthreads();
    *(u32x4*)((dummy ? (bf16*)(ws + WS_AP) : KK) + (tok0 + (tid >> 3)) * 1024 + col0 + 8 * (tid & 7)) = *(const LAS u32x4*)(RWB(15) + (tid >> 3) * RWP + 8 * (tid & 7));
    const int qt = wave & 3, tm4 = qt >> 1, tn4 = qt & 1;
    f32x16 Treg = f16zero();
    if (wave < 4) { f32x16 x = rw_tile(RWB(11), RWB(12), tm4, tn4, r, h, f16zero()); rw_store_rm(RWB(0), tm4, tn4, r, h, x); rw_store_tr(RWB(1), tm4, tn4, r, h, x); }
    else { f32x16 x = rw_tile(RWB(8), RWB(7), tm4, tn4, r, h, f16zero()); rw_store_tr(RWB(14), tm4, tn4, r, h, x);
#pragma unroll
        for (int i = 0; i < 16; ++i) Treg[i] = bf2f(RWB(13)[(32 * tm4 + crow(i, h)) * RWP + 32 * tn4 + r]); }
    __syncthreads();
    if (lru_m >= 0) lru_fin_store(a, lru_m, lru_jh, lane, lfr);
#pragma unroll
    for (int st = 0; st < 5; ++st) {
        const bool odd = (st & 1) != 0;
        const LAS bf16* Lr = odd ? RWB(11) : RWB(0); const LAS bf16* Lt = odd ? RWB(12) : RWB(1);
        if (wave < 4) { if (st < 4) { f32x16 x = rw_tile(Lr, Lt, tm4, tn4, r, h, f16zero()); rw_store_rm(odd ? RWB(0) : RWB(11), tm4, tn4, r, h, x); rw_store_tr(odd ? RWB(1) : RWB(12), tm4, tn4, r, h, x); } }
        else { Treg = rw_tile(odd ? RWB(2) : RWB(13), Lt, tm4, tn4, r, h, Treg); rw_store_rm(odd ? RWB(13) : RWB(2), tm4, tn4, r, h, Treg); }
        __syncthreads();
    }
    if (wave < 4) { f32x16 x = rw_tile(RWB(2), RWB(4), tm4, tn4, r, h, f16zero()); rw_store_tr(RWB(15), tm4, tn4, r, h, x); }
    else { f32x16 x = rw_tile(RWB(2), RWB(14), tm4, tn4, r, h, f16zero()); rw_store_tr(RWB(8), tm4, tn4, r, h, x); }
    __syncthreads();
    {
        const int mat = wave >> 1, tm = wave & 1;
        bf16* dst = dummy ? (bf16*)(ws + WS_AP) : (mat == 0) ? Rg : (mat == 1) ? BBg : (mat == 2) ? EW : KP;
#pragma unroll
        for (int tn = 0; tn < 2; ++tn) {
            f32x16 x = f16zero();
            if (mat == 0) x = rw_tile(RWB(15), RWB(9), tm, tn, r, h, x);
            else if (mat == 1) { x = rw_tile(RWB(8), RWB(9), tm, tn, r, h, x); x = rw_tile(RWB(7), RWB(10), tm, tn, r, h, x); }
            else if (mat == 2) x = rw_tile(RWB(15), RWB(5), tm, tn, r, h, x);
            else { x = rw_tile(RWB(5), RWB(8), tm, tn, r, h, x); x = rw_tile(RWB(6), RWB(7), tm, tn, r, h, x); }
            const int n = 32 * tn + r;
#pragma unroll
            for (int g = 0; g < 4; ++g) { const int m = 32 * tm + 8 * g + 4 * h;
                f32x4 o = (f32x4){x[4 * g], x[4 * g + 1], x[4 * g + 2], x[4 * g + 3]};
                if (mat == 0) { const u32x2 w = *(const LAS u32x2*)(RWB(3) + n * RWP + m); o += (f32x4){bflo(w.x), bfhi(w.x), bflo(w.y), bfhi(w.y)}; }
                if (mat == 2) { const float gc = GC[n];
#pragma unroll
                    for (int e = 0; e < 4; ++e) if (m + e == n) o[e] += gc; }
                { u32x2 ow; ow.x = cvtpk(o.x, o.y); ow.y = cvtpk(o.z, o.w); *(LAS u32x2*)(RWB(11 + mat) + n * RWP + m) = ow; }
                }
        }
        (void)dst;
    }
    __syncthreads();
#pragma unroll
    for (int q = 0; q < 4; ++q) { bf16* dq = dummy ? (bf16*)(ws + WS_AP) : (q == 0) ? Rg : (q == 1) ? BBg : (q == 2) ? EW : KP;
        *(u32x4*)(dq + (tok0 + (tid >> 3)) * 1024 + col0 + 8 * (tid & 7)) = *(const LAS u32x4*)(RWB(11 + q) + (tid >> 3) * RWP + 8 * (tid & 7)); }
    if (cvt_it >= 0) cvt_item_finish(a, l, cvt_it, lane, cvr, (LAS float*)(lds + wave * 9216));
    __syncthreads();
}

constexpr int RW2_SLOT = 10240, RW2_NSLOT = 5, RW2_RING_OFF = 4096, RW2_RING_END = RW2_RING_OFF + RW2_NSLOT * RW2_SLOT;
DI void rw2_chain(const PA& a, int bh, int ib, LAS unsigned char* lds, int lane) {
    unsigned char* ws = a.ws; const bf16* EW = (const bf16*)(ws + WS_OM); const bf16* KP = (const bf16*)(ws + WS_KP); bf16* Vg = (bf16*)(ws + WS_V);
    LAS bf16* Sl = (LAS bf16*)lds;
    LAS unsigned char* ring = lds + RW2_RING_OFF;
    const int b = bh >> 4, hd = bh & 15, col0 = hd * 64, fr = lane & 15, fq = lane >> 4; const size_t tokb = (size_t)b * S;
    for (int idx = lane; idx < 16 * RWP / 2; idx += 64) ((LAS unsigned*)Sl)[idx] = 0u;
    { bf16* z0 = Vg + (tokb + 16 * ib + fr) * 1024 + col0 + 16 * fq; const u32x4 zz = zero4(); *(u32x4*)z0 = zz; *(u32x4*)(z0 + 8) = zz; }
    const int prow = lane >> 3, pchk = lane & 7;
    const bf16* pg = EW + (tokb + prow) * 1024 + col0;
    const bf16* qg = KP + (tokb + 16 * ib + prow) * 1024 + col0 + 8 * pchk;
    const int psw = 8 * (pchk ^ prow);
#define RW2_DMA(ck_) do { const int c_ = (ck_) < S / 64 ? (ck_) : S / 64 - 1; const int sl_ = (ck_) % RW2_NSLOT; LAS unsigned char* sb_ = ring + sl_ * RW2_SLOT; \
        _Pragma("unroll") for (int i_ = 0; i_ < 8; ++i_) __builtin_amdgcn_global_load_lds((const unsigned*)(pg + (size_t)(64 * c_ + 8 * i_) * 1024 + psw), (LAS unsigned*)(sb_ + i_ * 1024), 16, 0, 0); \
        _Pragma("unroll") for (int i_ = 0; i_ < 2; ++i_) __builtin_amdgcn_global_load_lds((const unsigned*)(qg + (size_t)(64 * c_ + 8 * i_) * 1024), (LAS unsigned*)(sb_ + 8192 + i_ * 1024), 16, 0, 0); } while (0)
    RW2_DMA(0); RW2_DMA(1); RW2_DMA(2); RW2_DMA(3);
    asm volatile("s_waitcnt vmcnt(0) lgkmcnt(0)" ::: "memory");
#pragma nounroll
    for (int ck = 0; ck < S / 64; ++ck) {
        asm volatile("s_waitcnt vmcnt(42)" ::: "memory");
        const LAS unsigned char* sb = ring + (ck % RW2_NSLOT) * RW2_SLOT;
        const bf16x8 s0 = *(const LAS bf16x8*)(Sl + fr * RWP + 8 * fq), s1 = *(const LAS bf16x8*)(Sl + fr * RWP + 32 + 8 * fq);
        f32x4 z[4];
#pragma unroll
        for (int jt = 0; jt < 4; ++jt) { const int row = 16 * jt + fr;
            const u32x2 qv = *(const LAS u32x2*)(sb + 8192 + fr * 128 + 32 * jt + 8 * fq);
            f32x4 acc = (f32x4){bflo(qv.x), bfhi(qv.x), bflo(qv.y), bfhi(qv.y)};
            const bf16x8 p0 = *(const LAS bf16x8*)(sb + row * 128 + 16 * (fq ^ (row & 7))), p1 = *(const LAS bf16x8*)(sb + row * 128 + 16 * ((4 + fq) ^ (row & 7)));
            acc = MFMA16(p0, s0, acc); acc = MFMA16(p1, s1, acc); z[jt] = acc; }
        LDS_WAIT();
#pragma unroll
        for (int jt = 0; jt < 4; ++jt) { u32x2 w; w.x = cvtpk(z[jt][0], z[jt][1]); w.y = cvtpk(z[jt][2], z[jt][3]);
            *(LAS u32x2*)(Sl + fr * RWP + 16 * jt + 4 * fq) = w;
            const int cn = ck + 1 < S / 64 ? ck + 1 : 0;
            if (ck + 1 < S / 64) *(u32x2*)(Vg + (tokb + (size_t)cn * 64 + 16 * ib + fr) * 1024 + col0 + 16 * jt + 4 * fq) = w; }
        LDS_WAIT();
        RW2_DMA(ck + 4);
    }
    asm volatile("s_waitcnt vmcnt(0)" ::: "memory");
#undef RW2_DMA
}

DI void rw3_unit(const PA& a, int l, int item, int lane, LAS unsigned char* wl) {
    unsigned char* ws = a.ws; const bf16* Sg = (const bf16*)(ws + WS_V); const bf16* Rg = (const bf16*)(ws + WS_R); const bf16* YL = (const bf16*)(ws + WS_BB); const bf16* BV = (const bf16*)(ws + WS_KK);
    const bf16* Gb = (const bf16*)(ws + WS_G); bf16* YC = (bf16*)(ws + WS_YC);
    const int th = item & 1, ck = (item >> 1) & 127, bh = item >> 8, b = bh >> 4, hd = bh & 15, col0 = hd * 64, r = lane & 31, h = lane >> 5;
    const size_t tok0 = (size_t)b * S + (size_t)ck * 64; const size_t trow = tok0 + 32 * th + r;
    const int srow = lane >> 3, schk = lane & 7; const size_t sg = (tok0 + 32 * th + srow) * 1024 + col0 + 8 * schk;
    u32x4 tl[3][4];
#pragma unroll
    for (int i = 0; i < 4; ++i) { tl[0][i] = *(const u32x4*)(YL + sg + (size_t)(8 * i) * 1024); tl[1][i] = *(const u32x4*)(BV + sg + (size_t)(8 * i) * 1024); tl[2][i] = *(const u32x4*)(Gb + sg + (size_t)(8 * i) * 1024); }
    f32x16 y[2]; y[0] = f16zero(); y[1] = f16zero();
    { const bf16* rp = Rg + trow * 1024 + col0 + 8 * h;
#pragma unroll
      for (int ks = 0; ks < 4; ++ks) { const bf16x8 bfr = *(const bf16x8*)(rp + 16 * ks);
#pragma unroll
          for (int ti = 0; ti < 2; ++ti) y[ti] = MFMA32(*(const bf16x8*)(Sg + (tok0 + 32 * ti + r) * 1024 + col0 + 16 * ks + 8 * h), bfr, y[ti]); } }
#pragma unroll
    for (int q = 0; q < 3; ++q)
#pragma unroll
        for (int i = 0; i < 4; ++i) *(LAS u32x4*)(wl + q * 4608 + (8 * i + srow) * 144 + 16 * schk) = tl[q][i];
    LDS_WAIT();
    float sum = 0.f;
#pragma unroll
    for (int ti = 0; ti < 2; ++ti)
#pragma unroll
        for (int g = 0; g < 4; ++g) { const u32x2 w = *(const LAS u32x2*)(wl + r * 144 + 2 * (32 * ti + 8 * g + 4 * h));
            y[ti][4 * g] += bflo(w.x); y[ti][4 * g + 1] += bfhi(w.x); y[ti][4 * g + 2] += bflo(w.y); y[ti][4 * g + 3] += bfhi(w.y);
            sum += (y[ti][4 * g] + y[ti][4 * g + 1]) + (y[ti][4 * g + 2] + y[ti][4 * g + 3]); }
    sum += SHX(sum, 32);
    const float mean = sum * (1.0f / 64.0f); float sq = 0.f;
#pragma unroll
    for (int ti = 0; ti < 2; ++ti)
#pragma unroll
        for (int i = 0; i < 16; ++i) { const float d = y[ti][i] - mean; y[ti][i] = d; sq += d * d; }
    sq += SHX(sq, 32);
    const float rstd = 1.0f / sqrtf(sq * (1.0f / 64.0f) + 64e-5f);
    const float* lw = a.in[I_LNW] + l * 1024 + col0; const float* lb = a.in[I_LNB] + l * 1024 + col0;
#pragma unroll
    for (int ti = 0; ti < 2; ++ti)
#pragma unroll
        for (int g = 0; g < 4; ++g) { const int i0 = 32 * ti + 8 * g + 4 * h;
            const u32x2 wb = *(const LAS u32x2*)(wl + 4608 + r * 144 + 2 * i0), wg = *(const LAS u32x2*)(wl + 9216 + r * 144 + 2 * i0);
            const f32x4 bvv = (f32x4){bflo(wb.x), bfhi(wb.x), bflo(wb.y), bfhi(wb.y)}, gg = (f32x4){bflo(wg.x), bfhi(wg.x), bflo(wg.y), bfhi(wg.y)};
            const f32x4 w4 = *(const f32x4*)(lw + i0), b4 = *(const f32x4*)(lb + i0);
            const f32x4 d = (f32x4){y[ti][4 * g], y[ti][4 * g + 1], y[ti][4 * g + 2], y[ti][4 * g + 3]};
            const f32x4 o = (d * rstd * w4 + b4 + bvv) * gg;
            u32x2 ow; ow.x = cvtpk(o.x, o.y); ow.y = cvtpk(o.z, o.w); *(LAS u32x2*)(wl + 13824 + r * 144 + 2 * i0) = ow; }
    LDS_WAIT();
#pragma unroll
    for (int i = 0; i < 4; ++i) *(u32x4*)(YC + sg + (size_t)(8 * i) * 1024) = *(const LAS u32x4*)(wl + 13824 + (8 * i + srow) * 144 + 16 * schk);
    LDS_WAIT();
}

#define DPPI(x_, ctrl_, rm_, bc_) __builtin_amdgcn_update_dpp(0, (int)(x_), ctrl_, rm_, 0xf, bc_)
DI unsigned wave_max_u32_dpp(unsigned x) {
    unsigned y;
    y = (unsigned)DPPI(x, 0x111, 0xf, true); x = x > y ? x : y; y = (unsigned)DPPI(x, 0x112, 0xf, true); x = x > y ? x : y;
    y = (unsigned)DPPI(x, 0x114, 0xf, true); x = x > y ? x : y; y = (unsigned)DPPI(x, 0x118, 0xf, true); x = x > y ? x : y;
    y = (unsigned)DPPI(x, 0x142, 0xa, false); x = x > y ? x : y; y = (unsigned)DPPI(x, 0x143, 0xc, false); x = x > y ? x : y;
    return (unsigned)__builtin_amdgcn_readlane((int)x, 63);
}
DI float wave_sum_dpp(float v) {
#define DPPF(ctrl_, rm_, bc_) __builtin_bit_cast(float, __builtin_amdgcn_update_dpp(0, __builtin_bit_cast(int, v), ctrl_, rm_, 0xf, bc_))
    v += DPPF(0x111, 0xf, true); v += DPPF(0x112, 0xf, true); v += DPPF(0x114, 0xf, true); v += DPPF(0x118, 0xf, true); v += DPPF(0x142, 0xa, false); v += DPPF(0x143, 0xc, false);
#undef DPPF
    return __builtin_bit_cast(float, __builtin_amdgcn_readlane(__builtin_bit_cast(int, v), 63));
}
DI void router_raw(const bf16* x1, int m, int lane, u32x2 (&raw)[4]) {
#pragma unroll
    for (int j = 0; j < 4; ++j) raw[j] = *(const u32x2*)(x1 + (size_t)m * 1024 + 4 * lane + 256 * j);
}
DI void router_row(const LAS float* MOD, const u32x2 (&raw)[4], bf16* H, int m, int lane, f32x4 (&v)[4]) {
    float ss = 0.f;
#pragma unroll
    for (int j = 0; j < 4; ++j) { v[j] = (f32x4){bflo(raw[j].x), bfhi(raw[j].x), bflo(raw[j].y), bfhi(raw[j].y)}; ss += (v[j].x * v[j].x + v[j].y * v[j].y) + (v[j].z * v[j].z + v[j].w * v[j].w); }
    const float rstd = 1.0f / sqrtf(wave_sum_dpp(ss) * (1.0f / 1024.0f) + 1e-6f);
#pragma unroll
    for (int j = 0; j < 4; ++j) { const int col = 4 * lane + 256 * j;
        v[j] = v[j] * rstd * *(const LAS f32x4*)(MOD + col) + *(const LAS f32x4*)(MOD + 1024 + col);
        store4bf(H + (size_t)m * 1024 + col, v[j]); }
}
DI float router_reduce(float (&p)[16], float be, int lane) {
#pragma unroll
    for (int e = 0; e < 8; ++e) { const bool up = (lane & 16) != 0; const float send = up ? p[e] : p[e + 8], keep = up ? p[e + 8] : p[e]; p[e] = keep + SHX(send, 16); }
#pragma unroll
    for (int e = 0; e < 4; ++e) { const bool up = (lane & 8) != 0; const float send = up ? p[e] : p[e + 4], keep = up ? p[e + 4] : p[e]; p[e] = keep + SHX(send, 8); }
#pragma unroll
    for (int e = 0; e < 2; ++e) { const bool up = (lane & 4) != 0; const float send = up ? p[e] : p[e + 2], keep = up ? p[e + 2] : p[e]; p[e] = keep + SHX(send, 4); }
    { const bool up = (lane & 2) != 0; const float send = up ? p[0] : p[1], keep = up ? p[1] : p[0]; p[0] = keep + SHX(send, 2); }
    float lg = p[0] + SHX(p[0], 1) + be; lg = (lg == lg) ? fminf(fmaxf(lg, -1.0e30f), 1.0e30f) : 0.f;
    return lg;
}
DI unsigned router_key(float lg, int e_own) { const unsigned u = __builtin_bit_cast(unsigned, lg); const unsigned o = (u & 0x80000000u) ? ~u : (u | 0x80000000u); return (o & ~31u) | (unsigned)(31 - e_own); }
DI void router_emit(const float (&tv)[4], const int (&ti)[4], int m, int sb, int lane, float* topw, LAS unsigned* hist, LAS unsigned* sel) {
    const float e1 = __expf(tv[1] - tv[0]), e2 = __expf(tv[2] - tv[0]), e3 = __expf(tv[3] - tv[0]); const float inv = 1.0f / (1.0f + e1 + e2 + e3);
    if (lane < 4) { const int id = lane == 0 ? ti[0] : lane == 1 ? ti[1] : lane == 2 ? ti[2] : ti[3]; const float w = (lane == 0 ? 1.0f : lane == 1 ? e1 : lane == 2 ? e2 : e3) * inv;
        topw[m * 4 + lane] = w;
        const unsigned rank = __hip_atomic_fetch_add(hist + id, 1u, __ATOMIC_RELAXED, __HIP_MEMORY_SCOPE_WORKGROUP); sel[sb + lane] = ((unsigned)id << 20) | rank; }
}
DI void router_top4(float lg, int e_own, int m, int sb, int lane, float* topw, LAS unsigned* hist, LAS unsigned* sel) {
    unsigned kA = router_key(lg, e_own);
    float tv[4]; int ti[4];
#pragma unroll
    for (int k = 0; k < 4; ++k) {
        const unsigned xA = wave_max_u32_dpp(kA);
        const int eA = 31 - (int)(xA & 31u);
        ti[k] = eA; tv[k] = __builtin_bit_cast(float, __builtin_amdgcn_readlane(__builtin_bit_cast(int, lg), 2 * eA));
        if (e_own == eA) kA = 0u; }
    router_emit(tv, ti, m, sb, lane, topw, hist, sel);
}
DI void ph_router(const PA& a, int l, LAS unsigned char* lds, int tid, int lane, int wave, int gw, int cslot) {
    unsigned char* ws = a.ws; const float* ADA = (const float*)(ws + WS_ADA);
    constexpr int WP = 1032;
    LAS bf16* WH = (LAS bf16*)lds; LAS bf16* WL = (LAS bf16*)(lds + 66048);
    LAS float* MOD = (LAS float*)(lds + 132096);
    LAS unsigned* hist = (LAS unsigned*)(lds + 140288);
    LAS unsigned* sel = hist + 64;
    LAS float* LG = (LAS float*)(lds + 142592) + wave * 528;
    const float* wr = a.in[I_WR] + (size_t)l * 1024 * 32;
    {
        f32x4 wv[16];
#pragma unroll
        for (int q = 0; q < 16; ++q) wv[q] = *(const f32x4*)(wr + 4 * (tid + 512 * q));
#pragma unroll
        for (int q = 0; q < 16; ++q) { const int idx = 4 * (tid + 512 * q), k = idx >> 5, e = idx & 31;
#pragma unroll
            for (int c = 0; c < 4; ++c) { const float w = wv[q][c]; const bf16 hb = f2bf(w); WH[(e + c) * WP + k] = hb; WL[(e + c) * WP + k] = f2bf(w - bf2f(hb)); } } }
    if (tid < 32) hist[tid] = 0u;
    { const int bq = (int)blockIdx.x >> 6; const float* gain = a.in[I_NMOE] + l * 1024; const float* adb = ADA + (l * 4 + bq) * 6144;
        for (int idx = tid; idx < 1024; idx += 512) { MOD[idx] = gain[idx] * (1.0f + adb[4096 + idx]); MOD[1024 + idx] = adb[3072 + idx]; } }
    __syncthreads();
    const bf16* x1 = (const bf16*)(ws + WS_X1); bf16* H = (bf16*)(ws + WS_H); float* topw = (float*)(ws + WS_TOPW);
    const int e_own = lane >> 1; const float be = a.in[I_BR][l * 32 + e_own];
    {
        const int r = lane & 15, q = lane >> 4, m0 = gw * 16;
        const bf16* xrow = x1 + (size_t)(m0 + r) * 1024 + 8 * q; bf16* hrow = H + (size_t)(m0 + r) * 1024 + 8 * q;
#define RT_XLOAD(dst_, g_) do { _Pragma("unroll") for (int i_ = 0; i_ < 8; ++i_) dst_[i_] = *(const u32x4*)(xrow + 32 * (8 * (g_) + i_)); } while (0)
#define RT_SQ(src_) do { _Pragma("unroll") for (int i_ = 0; i_ < 8; ++i_) { float f_[8]; pg8::unpack8(src_[i_], f_); _Pragma("unroll") for (int j_ = 0; j_ < 8; ++j_) ss += f_[j_] * f_[j_]; } } while (0)
#define RT_PROC(src_, g_) do { _Pragma("unroll") for (int i = 0; i < 8; ++i) { const int col = 32 * (8 * (g_) + i) + 8 * q; \
                float f[8], hh[8], hf[8], lo[8]; pg8::unpack8(src_[i], f); \
                const f32x4 g0 = *(const LAS f32x4*)(MOD + col), g1 = *(const LAS f32x4*)(MOD + col + 4), s0 = *(const LAS f32x4*)(MOD + 1024 + col), s1 = *(const LAS f32x4*)(MOD + 1024 + col + 4); \
                _Pragma("unroll") for (int j = 0; j < 8; ++j) hh[j] = f[j] * rstd * (j < 4 ? g0[j & 3] : g1[j & 3]) + (j < 4 ? s0[j & 3] : s1[j & 3]); \
                const u32x4 hi = pg8::pack8(hh); pg8::unpack8(hi, hf); \
                _Pragma("unroll") for (int j = 0; j < 8; ++j) lo[j] = hh[j] - hf[j]; \
                const u32x4 lov = pg8::pack8(lo); \
                *(u32x4*)(hrow + 32 * (8 * (g_) + i)) = hi; \
                const bf16x8 ah = __builtin_bit_cast(bf16x8, hi), al = __builtin_bit_cast(bf16x8, lov); \
                const bf16x8 bh0 = *(const LAS bf16x8*)(WH + r * WP + col), bh1 = *(const LAS bf16x8*)(WH + (16 + r) * WP + col); \
                const bf16x8 bl0 = *(const LAS bf16x8*)(WL + r * WP + col), bl1 = *(const LAS bf16x8*)(WL + (16 + r) * WP + col); \
                acc0 = MFMA16(ah, bh0, acc0); acc0 = MFMA16(al, bh0, acc0); acc0 = MFMA16(ah, bl0, acc0); \
                acc1 = MFMA16(ah, bh1, acc1); acc1 = MFMA16(al, bh1, acc1); acc1 = MFMA16(ah, bl1, acc1); } } while (0)
        u32x4 xa[8], xb[8];
        float ss = 0.f;
#define SB_ __builtin_amdgcn_sched_barrier(0)
        RT_XLOAD(xa, 0); RT_XLOAD(xb, 1); SB_; RT_SQ(xa); SB_; RT_XLOAD(xa, 2); SB_; RT_SQ(xb); SB_; RT_XLOAD(xb, 3); SB_; RT_SQ(xa); SB_;
        RT_XLOAD(xa, 0);
        SB_; RT_SQ(xb); SB_;
        ss += SHX(ss, 16); ss += SHX(ss, 32);
        const float rstd = 1.0f / sqrtf(ss * (1.0f / 1024.0f) + 1e-6f);
        f32x4 acc0 = (f32x4){0.f, 0.f, 0.f, 0.f}, acc1 = acc0;
        RT_XLOAD(xb, 1); SB_; RT_PROC(xa, 0); SB_; RT_XLOAD(xa, 2); SB_; RT_PROC(xb, 1); SB_; RT_XLOAD(xb, 3); SB_; RT_PROC(xa, 2); SB_; RT_PROC(xb, 3); SB_;
#undef SB_
#undef RT_XLOAD
#undef RT_SQ
#undef RT_PROC
#pragma unroll
        for (int reg = 0; reg < 4; ++reg) { LG[(4 * q + reg) * 33 + r] = acc0[reg]; LG[(4 * q + reg) * 33 + 16 + r] = acc1[reg]; }
        LDS_WAIT();
#pragma nounroll
        for (int t = 0; t < 16; ++t) { float lg = LG[t * 33 + e_own] + be; lg = (lg == lg) ? fminf(fmaxf(lg, -1.0e30f), 1.0e30f) : 0.f;
            router_top4(lg, e_own, m0 + t, (wave * 16 + t) * 4, lane, topw, hist, sel); }
    }
    __syncthreads();
    if (tid < 32) { unsigned* cnt = (unsigned*)(ws + WS_CTL) + CW_CNT + 64 * cslot; const unsigned hv = hist[tid]; hist[32 + tid] = hv ? __hip_atomic_fetch_add(cnt + tid, hv, __ATOMIC_RELAXED, __HIP_MEMORY_SCOPE_AGENT) : 0u; }
    __syncthreads();
    { const unsigned v = sel[tid], e = v >> 20, widx = hist[32 + e] + (v & 0xFFFFFu); const int m = blockIdx.x * 128 + (tid >> 2);
        ((unsigned*)(ws + WS_TRAW))[m * 4 + (tid & 3)] = (e << 20) | widx; ((int*)(ws + WS_STOK))[e * M + widx] = m; }
    __syncthreads();
}

DI int build_expert_table(const PA& a, int l, LAS unsigned char* lds, int tid, int nct) {
    LAS int* tab = (LAS int*)(lds + TAB_OFF);
    {
        const unsigned* cnt = (const unsigned*)(a.ws + WS_CTL) + CW_CNT + 64 * l; int nb = 0, e0 = NE - 1, e1 = NE - 1; bool f0 = false, f1 = false;
        if (tid < NE) tab[672 + tid] = (int)cnt[tid];
        __syncthreads();
#pragma nounroll
        for (int e = 0; e < NE; ++e) { const int ce = tab[672 + e]; if (tid == e) tab[640 + e] = nb; nb += (ce + 255) >> 8; if (!f0 && tid < nb) { e0 = e; f0 = true; } if (!f1 && tid + 512 < nb) { e1 = e; f1 = true; } }
        tab[16 + tid] = e0; if (tid + 512 < 16 + 560) tab[16 + 512 + tid] = e1;
        if (tid == 0) tab[0] = nb; }
    __syncthreads();
    const int nblk = __builtin_amdgcn_readfirstlane(tab[0]);
    if (nct > 0) {
        { const int m = blockIdx.x * 128 + (tid >> 2); const unsigned v = ((const unsigned*)(a.ws + WS_TRAW))[m * 4 + (tid & 3)]; ((int*)(a.ws + WS_TSLOT))[m * 4 + (tid & 3)] = tab[640 + (v >> 20)] * 256 + (int)(v & 0xFFFFFu); }
        LAS int* rowt = (LAS int*)(lds + ROWT_OFF); const int* list = (const int*)(a.ws + WS_STOK);
        int tokv[9];
#pragma unroll
        for (int ii = 0; ii < 9; ++ii) { const int i = 2 * ii + (tid >> 8); int ct; const int blk = pg8::ExpertOrder<8>::unit_blk(i, (int)gridDim.x, (int)blockIdx.x, ct); tokv[ii] = 0;
            if (blk < nblk) { const int e = tab[16 + blk], w = (blk - tab[640 + e]) * 256 + (tid & 255); if (w < tab[672 + e]) tokv[ii] = list[e * M + w]; } }
#pragma unroll
        for (int ii = 0; ii < 9; ++ii) { const int i = 2 * ii + (tid >> 8); int ct; const int blk = pg8::ExpertOrder<8>::unit_blk(i, (int)gridDim.x, (int)blockIdx.x, ct);
            if (blk < nblk && i < 17) rowt[i * 256 + (tid & 255)] = tokv[ii]; }
        __syncthreads(); }
    return nblk;
}

#define LAUNDER() int tid = tid0; asm volatile("" : "+v"(tid)); tid &= 511; const int lane = tid & 63; (void)lane; int z_; asm volatile("s_mov_b32 %0, 0" : "=s"(z_)); const int gw = gw0 + z_; (void)gw; \
    unsigned char* ws = args.ws + z_; (void)ws; PA A; A.in = args.in + z_; A.out = args.out + z_; A.ws = ws; \
    bf16* const COLS = (bf16*)(ws + WS_COLS); bf16* const Hb = (bf16*)(ws + WS_H); const float* const ADA = (const float*)(ws + WS_ADA); (void)COLS; (void)Hb; (void)ADA
#ifndef PHMASK
#define PHMASK 0xFFFFu
#endif
#define IN(k) (lo <= (k) && (k) < hi)
#define EN(j) (((PHMASK) >> (j)) & 1u)
#ifndef REPMASK
#define REPMASK 0u
#endif
#define REP(j) (((REPMASK) >> (j)) & 1u)
#ifndef REPSUB
#define REPSUB 0u
#endif
#define RS(j) (1 + (int)(((REPSUB) >> (j)) & 1u))
#define SEAM(k) do { if (IN(k) && IN((k) + 1)) { XcdBarrier b2_ = bar; b2_.x = (unsigned)__builtin_amdgcn_readfirstlane((int)b2_.x); asm volatile("" : "+s"(b2_.x)); xcd_barrier(b2_); } } while (0)
#ifndef GEMM1_STAGGER
#define GEMM1_STAGGER 0
#endif
template <int L> DI void layer_body(const Args& args, LAS unsigned char* lds, const XcdBarrier& bar, const int tid0, const int wave, const int G, const int gw0, const int NGW, const int lo, const int hi) {
    constexpr int l = L; constexpr int pb = 1 + 13 * l;
        if (EN(0) && IN(pb + 0)) { LAUNDER(); if constexpr (L > 0) { ph_convert(A, l, lds, tid, lane, wave, gw, NGW); ph_norm(A, l, 1, lane, gw); } else ph_norm(A, l, 0, lane, gw); }
        if (REP(0) && IN(pb + 0)) { LAUNDER(); if constexpr (L > 0) { ph_convert(A, l, lds, tid, lane, wave, gw, NGW); ph_norm(A, l, 1, lane, gw); } else ph_norm(A, l, 0, lane, gw); }
        SEAM(pb + 0);
        if (EN(1) && IN(pb + 1)) { LAUNDER(); pg8::Gemm g{Hb, (const bf16*)(ws + WS_WIN), M, NIN, D}; pg8::StaticOrder So; So.init(M, NIN, G, (int)blockIdx.x);
#if GEMM1_STAGGER > 0
            if (blockIdx.x >= 128) {
#pragma nounroll
                for (int sl = 0; sl < GEMM1_STAGGER; ++sl) __builtin_amdgcn_s_sleep(127); }
#endif
            pg8::EpiPlainBf16 E{COLS, NIN};
            pg8::gemm_phase<pg8::EpiPlainBf16, pg8::StaticOrder, true, true>(lds, g, So, E); }
        if (REP(1) && IN(pb + 1)) { LAUNDER(); pg8::Gemm g{Hb, (const bf16*)(ws + WS_WIN), M, NIN, D}; pg8::StaticOrder So; So.init(M, NIN, G, (int)blockIdx.x);
            pg8::EpiPlainBf16 E{COLS, NIN};
            pg8::gemm_phase<pg8::EpiPlainBf16, pg8::StaticOrder, true, true>(lds, g, So, E); }
        SEAM(pb + 1);
        if (EN(2) && IN(pb + 2)) { LAUNDER();
#ifdef PREP_SEPARATE
            for (int rs = 0; rs < RS(0); ++rs) lru_phase(A, l, lds, tid, lane, wave);
            for (int rs = 0; rs < RS(1); ++rs) for (int it = gw; it < 8192; it += NGW) vt_item(COLS, (bf16*)(ws + WS_VT), it, (LAS bf16*)(lds + wave * 16384), lane);
            for (int rs = 0; rs < RS(2); ++rs) rw_prep_wave(A, l, gw * 16, lane);
#else
            lru_phase(A, l, lds, tid, lane, wave, gw * 16);
            for (int rs = 0; rs < RS(1); ++rs) for (int it = gw; it < 8192; it += NGW) vt_item(COLS, (bf16*)(ws + WS_VT), it, (LAS bf16*)(lds + wave * 16384), lane);
#endif
        }
        if (REP(2) && IN(pb + 2)) { LAUNDER();
            lru_phase(A, l, lds, tid, lane, wave);
            for (int it = gw; it < 8192; it += NGW) vt_item(COLS, (bf16*)(ws + WS_VT), it, (LAS bf16*)(lds + wave * 16384), lane);
            rw_prep_wave(A, l, gw * 16, lane);
        }
        SEAM(pb + 2);
        if (EN(3) && IN(pb + 3)) { LAUNDER(); lru_carry(A, tid); pg8::Gemm g{(const bf16*)(ws + WS_AP), (const bf16*)(ws + WS_LORAB), M, 3072, 256}; pg8::StaticOrder So; So.init(M, 3072, G, (int)blockIdx.x);
            pg8::EpiLora E{(bf16*)(ws + WS_OM), (bf16*)(ws + WS_BB), (bf16*)(ws + WS_KP), (const bf16*)(ws + WS_KK), (bf16*)(ws + WS_G), A.in[I_W0] + l * 1024, A.in[I_A0] + l * 1024, A.in[I_KA] + l * 1024};
            pg8::gemm_phase<pg8::EpiLora, pg8::StaticOrder, true, true>(lds, g, So, E); }
        if (REP(3) && IN(pb + 3)) { LAUNDER(); lru_carry(A, tid); pg8::Gemm g{(const bf16*)(ws + WS_AP), (const bf16*)(ws + WS_LORAB), M, 3072, 256}; pg8::StaticOrder So; So.init(M, 3072, G, (int)blockIdx.x);
            pg8::EpiLora E{(bf16*)(ws + WS_OM), (bf16*)(ws + WS_BB), (bf16*)(ws + WS_KP), (const bf16*)(ws + WS_KK), (bf16*)(ws + WS_G), A.in[I_W0] + l * 1024, A.in[I_A0] + l * 1024, A.in[I_KA] + l * 1024};
            pg8::gemm_phase<pg8::EpiLora, pg8::StaticOrder, true, true>(lds, g, So, E); }
        SEAM(pb + 3);
        if (EN(4) && IN(pb + 4)) { LAUNDER();
#ifdef LRU_FIN_SEPARATE
            for (int rs = 0; rs < RS(3); ++rs) { _Pragma("unroll 2") for (int i = 0; i < 16; ++i) lru_finish_row(A, gw * 16 + i, lane); }
#endif
            { u32x4 rin[6], rnx[6]; rw1_load(A, (int)blockIdx.x >> 7, (int)blockIdx.x & 127, lane, wave, rin);
              for (int u = blockIdx.x; u < 8192; u += G) { const int un = u + G; rw1_unit(A, l, u >> 7, u & 127, lds, tid, lane, wave, rin, un < 8192, un >> 7, un & 127, rnx, (u >> 8) < 24 ? ((int)blockIdx.x * 8 + wave) * 24 + (u >> 8) : -1,
#ifdef LRU_FIN_SEPARATE
                    -1, 0);
#else
                    gw * 16 + (u >> 9), (u >> 8) & 1);
#endif
#pragma unroll
                  for (int q = 0; q < 6; ++q) rin[q] = rnx[q]; } }
        }
        if (REP(4) && IN(pb + 4)) { LAUNDER();
            { u32x4 rin[6], rnx[6]; rw1_load(A, (int)blockIdx.x >> 7, (int)blockIdx.x & 127, lane, wave, rin);
              for (int u = blockIdx.x; u < 8192; u += G) { const int un = u + G; rw1_unit(A, l, u >> 7, u & 127, lds, tid, lane, wave, rin, un < 8192, un >> 7, un & 127, rnx, -1, -1, 0, true);
#pragma unroll
                  for (int q = 0; q < 6; ++q) rin[q] = rnx[q]; } }
        }
        SEAM(pb + 4);
        if (EN(5) && IN(pb + 5)) { LAUNDER();
            if (wave == 0) {
#ifdef RW2_PRIO
                __builtin_amdgcn_s_setprio(RW2_PRIO);
#endif
                for (int rs = 0; rs < RS(5); ++rs) rw2_chain(A, (int)blockIdx.x >> 2, (int)blockIdx.x & 3, lds, lane);
#ifdef RW2_PRIO
                __builtin_amdgcn_s_setprio(0);
#endif
            }
#ifdef ATT_SKIP_W4
            else { const int aw = wave < 4 ? wave - 1 : wave - 2;
              if (wave != 4) for (int rs = 0; rs < RS(4); ++rs) for (int sk = aw; sk < 32; sk += 6) { const int it = (((int)blockIdx.x >> 3) << 8) + (((int)blockIdx.x & 7) << 5) + sk;
                attn_strip(COLS, (const bf16*)(ws + WS_VT), (bf16*)(ws + WS_YB), it, lane, lds + RW2_RING_END + aw * ATT_LDS); } }
#else
            else { if (wave <= 6) for (int rs = 0; rs < RS(4); ++rs) for (int sk = wave - 1; sk < 32; sk += 6) { const int it = (((int)blockIdx.x >> 3) << 8) + (((int)blockIdx.x & 7) << 5) + sk;
                attn_strip(COLS, (const bf16*)(ws + WS_VT), (bf16*)(ws + WS_YB), it, lane, lds + RW2_RING_END + (wave - 1) * ATT_LDS); } }
#endif
        }
        if (REP(5) && IN(pb + 5)) { LAUNDER();
            if (wave == 0) rw2_chain(A, (int)blockIdx.x >> 2, (int)blockIdx.x & 3, lds, lane);
            else if (wave <= 6) for (int sk = wave - 1; sk < 32; sk += 6) { const int it = (((int)blockIdx.x >> 3) << 8) + (((int)blockIdx.x & 7) << 5) + sk;
                attn_strip(COLS, (const bf16*)(ws + WS_VT), (bf16*)(ws + WS_YB), it, lane, lds + RW2_RING_END + (wave - 1) * ATT_LDS); }
        }
        SEAM(pb + 5);
        if (EN(12) && IN(pb + 6)) { LAUNDER(); for (int it = gw; it < 16384; it += NGW) rw3_unit(A, l, it, lane, lds + wave * 18432); }
        if (REP(12) && IN(pb + 6)) { LAUNDER(); for (int it = gw; it < 16384; it += NGW) rw3_unit(A, l, it, lane, lds + wave * 18432); }
        SEAM(pb + 6);
        if (EN(6) && IN(pb + 7)) { LAUNDER(); pg8::StaticOrder So; So.init(M, D, G, (int)blockIdx.x); bf16* MG = (bf16*)(ws + WS_VT); const bf16* PT = (const bf16*)(ws + WS_PT);
            { pg8::Gemm g{(const bf16*)(ws + WS_YA), PT, M, D, D}; pg8::EpiMerge<0> E{MG, COLS}; pg8::gemm_phase<pg8::EpiMerge<0>, pg8::StaticOrder, true, true>(lds, g, So, E); }
            { pg8::Gemm g{(const bf16*)(ws + WS_YB), PT + (size_t)D * D, M, D, D}; pg8::EpiMerge<1> E{MG, COLS}; pg8::gemm_phase<pg8::EpiMerge<1>, pg8::StaticOrder, true, true>(lds, g, So, E); }
            { pg8::Gemm g{(const bf16*)(ws + WS_YC), PT + (size_t)2 * D * D, M, D, D}; pg8::EpiMerge<2> E{MG, COLS}; pg8::gemm_phase<pg8::EpiMerge<2>, pg8::StaticOrder, true, true>(lds, g, So, E); } }
        if (REP(6) && IN(pb + 7)) { LAUNDER(); pg8::StaticOrder So; So.init(M, D, G, (int)blockIdx.x); bf16* MG = (bf16*)(ws + WS_VT); const bf16* PT = (const bf16*)(ws + WS_PT);
            { pg8::Gemm g{(const bf16*)(ws + WS_YA), PT, M, D, D}; pg8::EpiMerge<0> E{MG, COLS}; pg8::gemm_phase<pg8::EpiMerge<0>, pg8::StaticOrder, true, true>(lds, g, So, E); }
            { pg8::Gemm g{(const bf16*)(ws + WS_YB), PT + (size_t)D * D, M, D, D}; pg8::EpiMerge<1> E{MG, COLS}; pg8::gemm_phase<pg8::EpiMerge<1>, pg8::StaticOrder, true, true>(lds, g, So, E); }
            { pg8::Gemm g{(const bf16*)(ws + WS_YC), PT + (size_t)2 * D * D, M, D, D}; pg8::EpiMerge<2> E{MG, COLS}; pg8::gemm_phase<pg8::EpiMerge<2>, pg8::StaticOrder, true, true>(lds, g, So, E); } }
        SEAM(pb + 7);
        if (EN(7) && IN(pb + 8)) { LAUNDER(); pg8::Gemm g{(const bf16*)(ws + WS_VT), (const bf16*)(ws + WS_WOUT), M, D, D}; pg8::StaticOrder So; So.init(M, D, G, (int)blockIdx.x);
            pg8::EpiResid<(L > 0)> E{L == 0 ? (const void*)A.in[I_X] : (const void*)(ws + WS_X2), (bf16*)(ws + WS_X1), ADA + (size_t)l * 4 * 6144 + 2048};
            pg8::gemm_phase<pg8::EpiResid<(L > 0)>, pg8::StaticOrder, true, true>(lds, g, So, E); }
        if (REP(7) && IN(pb + 8)) { LAUNDER(); pg8::Gemm g{(const bf16*)(ws + WS_VT), (const bf16*)(ws + WS_WOUT), M, D, D}; pg8::StaticOrder So; So.init(M, D, G, (int)blockIdx.x);
            pg8::EpiResid<(L > 0)> E{L == 0 ? (const void*)A.in[I_X] : (const void*)(ws + WS_X2), (bf16*)(ws + WS_X1), ADA + (size_t)l * 4 * 6144 + 2048};
            pg8::gemm_phase<pg8::EpiResid<(L > 0)>, pg8::StaticOrder, true, true>(lds, g, So, E); }
        SEAM(pb + 8);
        if (EN(8) && IN(pb + 9)) { LAUNDER(); for (int rs = 0; rs < RS(6); ++rs) ph_router(A, l, lds, tid, lane, wave, gw, rs + 1 < RS(6) ? l + 2 : l); }
        if (REP(8) && IN(pb + 9)) { LAUNDER(); for (int rs = 0; rs < RS(6); ++rs) ph_router(A, l, lds, tid, lane, wave, gw, rs + 1 < RS(6) ? l + 2 : l); }
        SEAM(pb + 9);
        if (EN(10) && IN(pb + 11)) { LAUNDER(); const int nblk = build_expert_table(A, l, lds, tid, 8);
            pg8::Gemm g{Hb, (const bf16*)(ws + WS_WGU), nblk * 256, NE * 2048, D};
            pg8::ExpertOrder<8> So{nblk, G, (int)blockIdx.x, (const LAS int*)(lds + TAB_OFF) + 16, (const LAS int*)(lds + ROWT_OFF)};
            pg8::EpiSwiglu E{(bf16*)(ws + WS_ACT), A.in[I_BGU] + (size_t)l * NE * 2048};
            pg8::gemm_phase<pg8::EpiSwiglu, pg8::ExpertOrder<8>, true, true, true>(lds, g, So, E); }
        if (REP(10) && IN(pb + 11)) { LAUNDER(); const int nblk = build_expert_table(A, l, lds, tid, 8);
            pg8::Gemm g{Hb, (const bf16*)(ws + WS_WGU), nblk * 256, NE * 2048, D};
            pg8::ExpertOrder<8> So{nblk, G, (int)blockIdx.x, (const LAS int*)(lds + TAB_OFF) + 16, (const LAS int*)(lds + ROWT_OFF)};
            pg8::EpiSwiglu E{(bf16*)(ws + WS_ACT), A.in[I_BGU] + (size_t)l * NE * 2048};
            pg8::gemm_phase<pg8::EpiSwiglu, pg8::ExpertOrder<8>, true, true, true>(lds, g, So, E); }
        SEAM(pb + 11);
        if (EN(11) && IN(pb + 12)) { LAUNDER(); const int nblk = build_expert_table(A, l, lds, tid, 0);
            pg8::Gemm g{(const bf16*)(ws + WS_ACT), (const bf16*)(ws + WS_WD), nblk * 256, NE * 1024, D};
            pg8::ExpertOrder<4> So{nblk, G, (int)blockIdx.x, (const LAS int*)(lds + TAB_OFF) + 16, nullptr};
            pg8::EpiDown E{(bf16*)(ws + WS_YBUF), A.in[I_BDN] + (size_t)l * NE * 1024};
            pg8::gemm_phase<pg8::EpiDown, pg8::ExpertOrder<4>, true, true>(lds, g, So, E); }
        if (REP(11) && IN(pb + 12)) { LAUNDER(); const int nblk = build_expert_table(A, l, lds, tid, 0);
            pg8::Gemm g{(const bf16*)(ws + WS_ACT), (const bf16*)(ws + WS_WD), nblk * 256, NE * 1024, D};
            pg8::ExpertOrder<4> So{nblk, G, (int)blockIdx.x, (const LAS int*)(lds + TAB_OFF) + 16, nullptr};
            pg8::EpiDown E{(bf16*)(ws + WS_YBUF), A.in[I_BDN] + (size_t)l * NE * 1024};
            pg8::gemm_phase<pg8::EpiDown, pg8::ExpertOrder<4>, true, true>(lds, g, So, E); }
        SEAM(pb + 12);

}
__global__ void __launch_bounds__(512, 2) fwd(Args args) {
    extern __shared__ __attribute__((aligned(16))) unsigned char lds_raw[];
    LAS unsigned char* lds = (LAS unsigned char*)lds_raw;
    const int tid0 = threadIdx.x, wave = __builtin_amdgcn_readfirstlane(tid0 >> 6);
    const int G = gridDim.x, gw0 = blockIdx.x * 8 + wave, NGW = G * 8;
    volatile LAS unsigned* MISC = (volatile LAS unsigned*)(lds + MISC_OFF);
    if (tid0 < 64) MISC[tid0] = 0u;
    __syncthreads();
    unsigned* ctl = (unsigned*)(args.ws + WS_CTL);
    XcdBarrier bar; bar.bar = ctl + CW_BAR; bar.x = 0; bar.st = nullptr;
    if (!MK_PER_PHASE) bar = xcd_barrier_post(ctl + CW_BAR, MISC + 8);
#if MK_PER_PHASE
    const int lo = args.ph_lo, hi = args.ph_hi;
#else
    constexpr int lo = 0, hi = N_PHASES;
#endif


    if (IN(0)) { LAUNDER(); ph_ada(A, lds, tid, lane, gw, NGW); ph_convert(A, 0, lds, tid, lane, wave, gw, NGW); }
    SEAM(0);
#ifdef PROBE_BARS
    for (int pb_ = 0; pb_ < PROBE_BARS; ++pb_) { SEAM(0); }
#endif

    layer_body<0>(args, lds, bar, tid0, wave, G, gw0, NGW, lo, hi);
    layer_body<1>(args, lds, bar, tid0, wave, G, gw0, NGW, lo, hi);
    if (IN(27)) { LAUNDER(); ph_norm(A, NL - 1, 2, lane, gw); }
#undef IN
#undef SEAM
}

extern "C" void kernel_launch(void* const* d_in, const int* in_sizes, int n_in, void* d_out, int out_size, void* d_ws, size_t ws_size, hipStream_t stream) {
    static int ready = 0;
    if (ready == 0) {
        if (n_in != 36 || in_sizes[0] != M * D || out_size != M * D || ws_size < WS_END) {
            fprintf(stderr, "kernel_launch: built for 36 inputs, x/out of %d floats, >= %zu bytes of workspace; got n_in %d, in0 %d, out %d, ws %zu; nothing launched\n", M * D, (size_t)WS_END, n_in, n_in > 0 ? in_sizes[0] : -1, out_size, ws_size);
            ready = -1; return; }
        if (hipFuncSetAttribute((const void*)fwd, hipFuncAttributeMaxDynamicSharedMemorySize, LDS_BYTES) != hipSuccess) { fprintf(stderr, "kernel_launch: hipFuncSetAttribute failed\n"); ready = -1; return; }
        int per_cu = 0;
        if (hipOccupancyMaxActiveBlocksPerMultiprocessor(&per_cu, (const void*)fwd, 512, LDS_BYTES) != hipSuccess || per_cu < 1) fprintf(stderr, "kernel_launch: note: occupancy query reports %d workgroups per CU\n", per_cu);
        (void)hipGetLastError();
        ready = 1;
    }
    if (ready < 0) return;
    if (hipMemsetAsync((char*)d_ws + WS_CTL, 0, CTL_ZERO_BYTES, stream) != hipSuccess) { fprintf(stderr, "kernel_launch: memset failed\n"); return; }
    Args a{};
    for (int i = 0; i < 36; ++i) a.in[i] = (const float*)d_in[i];
    a.out = (float*)d_out; a.ws = (unsigned char*)d_ws; a.li = 0; a.pad = 0;
    const int grid = 256;
#if MK_PER_PHASE
    for (int p = 0; p < N_PHASES; ++p) { a.ph_lo = p; a.ph_hi = p + 1; hipLaunchKernelGGL(fwd, dim3(grid), dim3(512), LDS_BYTES, stream, a); }
#else
    a.ph_lo = 0; a.ph_hi = N_PHASES;
    hipLaunchKernelGGL(fwd, dim3(grid), dim3(512), LDS_BYTES, stream, a);
#endif
    const hipError_t le = hipPeekAtLastError();
    if (le != hipSuccess) fprintf(stderr, "kernel_launch: launch failed: %s\n", hipGetErrorName(le));
}
```

```cpp
#include <hip/hip_runtime.h>
#include <cstdio>
#include <cstdint>
#include <type_traits>
#define LAS __attribute__((address_space(3)))
#ifndef PG8_WGM
#define PG8_WGM 4
#endif
namespace pg8 {
#define PG8_LAS __attribute__((address_space(3)))
typedef unsigned short bf16_t;
typedef short bf16x8 __attribute__((ext_vector_type(8)));
typedef float f32x4 __attribute__((ext_vector_type(4)));
typedef unsigned u32x4 __attribute__((ext_vector_type(4)));
constexpr int BM = 256, BK = 64, HALF = 128, HTB = HALF * BK * 2  , STAGE_BYTES = 8 * HTB, NXCD = 8, WGM = PG8_WGM;

__host__ __device__ __forceinline__ int lds_byte(int r, int c) { const int st = (r >> 4) * 2 + (c >> 5), rr = r & 15, cc = c & 31, ob = rr * 64 + cc * 2; return st * 1024 + (ob ^ (((ob >> 9) & 1) << 5)); }
__host__ __device__ __forceinline__ void stage_rc(int b, int& R, int& C) { const int st = b / 1024, sb = b % 1024, swz = sb ^ (((sb >> 9) & 1) << 5); R = (st >> 1) * 16 + swz / 64; C = (st & 1) * 32 + (swz % 64) / 2; }
__host__ __device__ __forceinline__ int perm32(int rho) { const int n = rho >> 4, i = rho & 15; return 8 * (i >> 2) + 4 * n + (i & 3); }

struct Unit { int pm, pn; };
struct Gemm { const bf16_t* A; const bf16_t* Bt; int M, N, K; };

template <class E, class = void> struct epi_perm2 { static constexpr bool v = false; };
template <class E> struct epi_perm2<E, std::void_t<decltype(E::PERM2)>> { static constexpr bool v = E::PERM2; };
struct StaticOrder {
    int nM, nN, nwg, G, c;
    __host__ __device__ void init(int M, int N, int G_, int c_) { nM = M / BM; nN = N / BM; nwg = nM * nN; G = G_; c = c_; }
    __host__ __device__ bool next(int i, Unit& u) const {
        const long L = (long)i * G + c; if (L >= nwg) return false;
        int wgid = (int)L; { const int q = nwg / NXCD, r = nwg % NXCD, xcd = wgid % NXCD, off = wgid / NXCD; wgid = (xcd < r ? xcd * (q + 1) : r * (q + 1) + (xcd - r) * q) + off; }
        const int nig = WGM * nN, gid = wgid / nig, fm = gid * WGM, gsz = (nM - fm) < WGM ? (nM - fm) : WGM;
        u.pm = fm + ((wgid % nig) % gsz); u.pn = (wgid % nig) / gsz; return true;
    }
    __device__ __forceinline__ void a_ready(const Unit&) const {}
    __device__ __forceinline__ void done(const Unit&) const {}
};

typedef float f32x2c __attribute__((ext_vector_type(2))); typedef __bf16 bf16x2c __attribute__((ext_vector_type(2)));
__device__ __forceinline__ unsigned cvt_pk_bf16(float lo, float hi) { const f32x2c v = {lo, hi}; const bf16x2c b = __builtin_convertvector(v, bf16x2c); return __builtin_bit_cast(unsigned, b); }
typedef float f32x2 __attribute__((ext_vector_type(2)));
typedef unsigned u32x2 __attribute__((ext_vector_type(2)));
__device__ __forceinline__ float bflo(unsigned w) { return __uint_as_float(w << 16); }
__device__ __forceinline__ float bfhi(unsigned w) { return __uint_as_float(w & 0xffff0000u); }
__device__ __forceinline__ float frcp(float x) { return __builtin_amdgcn_rcpf(x); }
__device__ __forceinline__ float sigm(float x) { return frcp(1.0f + __expf(-x)); }
__device__ __forceinline__ void unpack8(const u32x4 w, float (&f)[8]) { f[0] = bflo(w.x); f[1] = bfhi(w.x); f[2] = bflo(w.y); f[3] = bfhi(w.y); f[4] = bflo(w.z); f[5] = bfhi(w.z); f[6] = bflo(w.w); f[7] = bfhi(w.w); }
__device__ __forceinline__ u32x4 pack8(const float (&f)[8]) { u32x4 w; w.x = cvt_pk_bf16(f[0], f[1]); w.y = cvt_pk_bf16(f[2], f[3]); w.z = cvt_pk_bf16(f[4], f[5]); w.w = cvt_pk_bf16(f[6], f[7]); return w; }

#ifndef P2_MERGE
#define P2_MERGE 0
#endif
#ifndef P2_RESID
#define P2_RESID 0
#endif
struct EpiPlainBf16 {
    static constexpr bool PERM = true, AFTER_DRAIN = false;
    static constexpr bool PERM2 = true;
    static constexpr int WCS = 64, BJS = 32;
    bf16_t* O; int ldc;
    __device__ __forceinline__ void operator()(const f32x4 (&acc)[2][2][4][2], const Unit& u, int wr, int wc, int fr, int fq) const {
        const int row0 = u.pm * BM + wr * 64 + fr, col0 = u.pn * BM + wc * WCS + 8 * fq;
#ifdef PROBE_EPI2
        for (int rep_ = 0; rep_ < 2; ++rep_) { asm volatile("" ::: "memory");
#endif
#pragma unroll
        for (int ai = 0; ai < 2; ++ai)
#pragma unroll
            for (int m = 0; m < 4; ++m) { bf16_t* rowp = O + (size_t)(row0 + ai * HALF + m * 16) * ldc + col0;
#pragma unroll
                for (int bj = 0; bj < 2; ++bj) { const f32x4 v0 = acc[ai][bj][m][0], v1 = acc[ai][bj][m][1];
                    u32x4 w; w.x = cvt_pk_bf16(v0[0], v0[1]); w.y = cvt_pk_bf16(v0[2], v0[3]); w.z = cvt_pk_bf16(v1[0], v1[1]); w.w = cvt_pk_bf16(v1[2], v1[3]);
                    *(u32x4*)(rowp + bj * BJS) = w; } }
#ifdef PROBE_EPI2
        }
#endif
    }
};

struct EpiLora {
    static constexpr bool PERM = true, AFTER_DRAIN = false;
    bf16_t* om; bf16_t* bb; bf16_t* kp; const bf16_t* kk; bf16_t* g; const float* w0; const float* a0; const float* ka;
    __device__ __forceinline__ void operator()(const f32x4 (&acc)[2][2][4][2], const Unit& u, int wr, int wc, int fr, int fq) const {
        const int sec = u.pn >> 2, row0 = u.pm * BM + wr * 64 + fr, col0 = (u.pn & 3) * BM + wc * 32 + 8 * fq;
#pragma unroll
        for (int bj = 0; bj < 2; ++bj) {
            const int col = col0 + bj * HALF;
            if (sec == 0) {
                const f32x4 wa = *(const f32x4*)(w0 + col), wb = *(const f32x4*)(w0 + col + 4);
#pragma unroll
                for (int ai = 0; ai < 2; ++ai)
#pragma unroll
                    for (int m = 0; m < 4; ++m) { const size_t off = (size_t)(row0 + ai * HALF + m * 16) * 1024 + col; float o[8];
#pragma unroll
                        for (int j = 0; j < 8; ++j) { const float z = acc[ai][bj][m][j >> 2][j & 3] + (j < 4 ? wa[j & 3] : wb[j & 3]); o[j] = 0.6065306597f * sigm(z); }
                        *(u32x4*)(om + off) = pack8(o); }
            } else if (sec == 1) {
                const f32x4 aa = *(const f32x4*)(a0 + col), ab = *(const f32x4*)(a0 + col + 4), ca = *(const f32x4*)(ka + col), cb = *(const f32x4*)(ka + col + 4);
#pragma unroll
                for (int ai = 0; ai < 2; ++ai)
#pragma unroll
                    for (int m = 0; m < 4; ++m) { const size_t off = (size_t)(row0 + ai * HALF + m * 16) * 1024 + col;
                        float kkf[8], krf[8], ob[8], ok[8]; unpack8(*(const u32x4*)(kk + off), kkf); unpack8(*(const u32x4*)(kp + off), krf);
#pragma unroll
                        for (int j = 0; j < 8; ++j) { const float a = sigm(acc[ai][bj][m][j >> 2][j & 3] + (j < 4 ? aa[j & 3] : ab[j & 3])); ob[j] = kkf[j] * a; ok[j] = krf[j] * (1.0f + (a - 1.0f) * (j < 4 ? ca[j & 3] : cb[j & 3])); }
                        *(u32x4*)(bb + off) = pack8(ob); *(u32x4*)(kp + off) = pack8(ok);
                        asm volatile("" ::: "memory"); }
            } else {
#pragma unroll
                for (int ai = 0; ai < 2; ++ai)
#pragma unroll
                    for (int m = 0; m < 4; ++m) { const size_t off = (size_t)(row0 + ai * HALF + m * 16) * 1024 + col; float o[8];
#pragma unroll
                        for (int j = 0; j < 8; ++j) o[j] = acc[ai][bj][m][j >> 2][j & 3];
                        *(u32x4*)(g + off) = pack8(o); }
            }
        }
    }
};

template <int STEP> struct EpiMerge {
    static constexpr bool PERM = true, AFTER_DRAIN = false, PERM2 = (P2_MERGE != 0);
    static constexpr int WCS = PERM2 ? 64 : 32, BJS = PERM2 ? 32 : HALF;
    bf16_t* O; const bf16_t* cols;
    __device__ __forceinline__ void operator()(const f32x4 (&acc)[2][2][4][2], const Unit& u, int wr, int wc, int fr, int fq) const {
        const int row0 = u.pm * BM + wr * 64 + fr, col0 = u.pn * BM + wc * WCS + 8 * fq;
#pragma unroll
        for (int ai = 0; ai < 2; ++ai)
#pragma unroll
            for (int m = 0; m < 4; ++m) {
#pragma unroll
                for (int bj = 0; bj < 2; ++bj) {
                    const int row = row0 + ai * HALF + m * 16, col = col0 + bj * BJS;
                    float gl[8], o[8]; unpack8(*(const u32x4*)(cols + (size_t)row * 11520 + 8448 + STEP * 1024 + col), gl);
                    if (STEP > 0) unpack8(*(const u32x4*)(O + (size_t)row * 1024 + col), o);
#pragma unroll
                    for (int j = 0; j < 8; ++j) { const float t = sigm(gl[j]) * acc[ai][bj][m][j >> 2][j & 3]; o[j] = (STEP > 0) ? o[j] + t : t; }
                    *(u32x4*)(O + (size_t)row * 1024 + col) = pack8(o);
                } }
    }
};

template <bool XIN_BF16> struct EpiResid {
    static constexpr bool PERM = true, AFTER_DRAIN = false, PERM2 = (P2_RESID != 0);
    static constexpr int WCS = PERM2 ? 64 : 32, BJS = PERM2 ? 32 : HALF;
    const void* xin; bf16_t* xout; const float* gmix;
    __device__ __forceinline__ void operator()(const f32x4 (&acc)[2][2][4][2], const Unit& u, int wr, int wc, int fr, int fq) const {
        const int row0 = u.pm * BM + wr * 64 + fr, col0 = u.pn * BM + wc * WCS + 8 * fq;
#pragma unroll
        for (int ai = 0; ai < 2; ++ai)
#pragma unroll
            for (int m = 0; m < 4; ++m) { const int row = row0 + ai * HALF + m * 16, b = row >> 13;
#pragma unroll
                for (int bj = 0; bj < 2; ++bj) { const int col = col0 + bj * BJS; const size_t off = (size_t)row * 1024 + col;
                    float xi[8], o[8];
                    if (XIN_BF16) unpack8(*(const u32x4*)((const bf16_t*)xin + off), xi);
                    else { const f32x4 a0 = *(const f32x4*)((const float*)xin + off), a1 = *(const f32x4*)((const float*)xin + off + 4);
                        xi[0] = a0[0]; xi[1] = a0[1]; xi[2] = a0[2]; xi[3] = a0[3]; xi[4] = a1[0]; xi[5] = a1[1]; xi[6] = a1[2]; xi[7] = a1[3]; }
                    const f32x4 g0 = *(const f32x4*)(gmix + b * 6144 + col), g1 = *(const f32x4*)(gmix + b * 6144 + col + 4);
#pragma unroll
                    for (int j = 0; j < 8; ++j) o[j] = xi[j] + (j < 4 ? g0[j & 3] : g1[j & 3]) * acc[ai][bj][m][j >> 2][j & 3];
                    *(u32x4*)(xout + off) = pack8(o); }
                asm volatile("" ::: "memory"); }
    }
};

struct EpiSwiglu {
    static constexpr bool PERM = true, AFTER_DRAIN = false;
    bf16_t* act; const float* bgu;
    __device__ __forceinline__ void operator()(const f32x4 (&acc)[2][2][4][2], const Unit& u, int wr, int wc, int fr, int fq) const {
        const int e = u.pn >> 3, ct = u.pn & 7, row0 = u.pm * BM + wr * 64 + fr, cl = ct * 128 + wc * 32 + 8 * fq;
        const float* bg = bgu + e * 2048 + cl; const float* bu = bg + 1024;
        const f32x4 g0 = *(const f32x4*)bg, g1 = *(const f32x4*)(bg + 4), u0 = *(const f32x4*)bu, u1 = *(const f32x4*)(bu + 4);
#pragma unroll
        for (int ai = 0; ai < 2; ++ai)
#pragma unroll
            for (int m = 0; m < 4; ++m) { const int row = row0 + ai * HALF + m * 16; float o[8];
#pragma unroll
                for (int j = 0; j < 8; ++j) {
                    float gt = acc[ai][0][m][j >> 2][j & 3] + (j < 4 ? g0[j & 3] : g1[j & 3]); float up = acc[ai][1][m][j >> 2][j & 3] + (j < 4 ? u0[j & 3] : u1[j & 3]);
                    gt = fminf(gt, 7.0f); up = fminf(fmaxf(up, -7.0f), 7.0f);
                    o[j] = (up + 1.0f) * gt * sigm(1.702f * gt); }
                *(u32x4*)(act + (size_t)row * 1024 + cl) = pack8(o); }
    }
};

struct EpiDown {
    static constexpr bool PERM = true, AFTER_DRAIN = false;
    bf16_t* yb; const float* bd;
    __device__ __forceinline__ void operator()(const f32x4 (&acc)[2][2][4][2], const Unit& u, int wr, int wc, int fr, int fq) const {
        const int e = u.pn >> 2, ct = u.pn & 3, row0 = u.pm * BM + wr * 64 + fr, col0 = ct * BM + wc * 32 + 8 * fq;
#pragma unroll
        for (int bj = 0; bj < 2; ++bj) { const int col = col0 + bj * HALF; const f32x4 b0 = *(const f32x4*)(bd + e * 1024 + col), b1 = *(const f32x4*)(bd + e * 1024 + col + 4);
#pragma unroll
            for (int ai = 0; ai < 2; ++ai)
#pragma unroll
                for (int m = 0; m < 4; ++m) { const int row = row0 + ai * HALF + m * 16; float o[8];
#pragma unroll
                    for (int j = 0; j < 8; ++j) o[j] = acc[ai][bj][m][j >> 2][j & 3] + (j < 4 ? b0[j & 3] : b1[j & 3]);
                    *(u32x4*)(yb + (size_t)row * 1024 + col) = pack8(o); } }
    }
};

template <int NCT> struct ExpertOrder {
    int nblk, G, c; const PG8_LAS int* blk_exp; const PG8_LAS int* rowt;
    __device__ __forceinline__ static int unit_blk(int i, int G_, int c_, int& ct) {
#ifdef EXP_RECT48
        if (NCT == 8) { const int x = c_ & 7, qq = c_ >> 3; ct = qq & 7; return (G_ / NCT) * i + 4 * x + (qq >> 3); }
#endif
        const int x = c_ & 7, qq = c_ >> 3, nh = NCT / 4, bg = x / nh, ch = x % nh; ct = 4 * ch + (qq & 3); return (G_ / NCT) * i + 8 * bg + (qq >> 2); }
    __device__ __forceinline__ bool next(int i, Unit& u) const {
        int ct; const int blk = unit_blk(i, G, c, ct); if (blk >= nblk) return false;
        const int e = __builtin_amdgcn_readfirstlane(blk_exp[blk]);
        u.pm = blk; u.pn = e * NCT + ct; return true;
    }
    __device__ __forceinline__ void a_ready(const Unit&) const {}
    __device__ __forceinline__ void done(const Unit&) const {}
};
template <class Epi, class Sched, bool ALIGN_EPI = false, bool SP2 = false, bool GATHER = false>
__device__ __forceinline__ void gemm_phase(PG8_LAS unsigned char* lds, const Gemm g, const Sched& S, const Epi& E) {
    int tid = threadIdx.x; asm volatile("" : "+v"(tid)); tid &= 511;
    const int wid = __builtin_amdgcn_readfirstlane(tid >> 6), lane = tid & 63, wr = wid >> 2, wc = wid & 3, fr = lane & 15, fq = lane >> 4;
    int K = g.K; asm volatile("" : "+s"(K));
    const int nt = K / BK;
    unsigned voffA[2], voffB[2];
#pragma unroll
    for (int i = 0; i < 2; ++i) { int R, C; stage_rc(tid * 16 + i * 8192, R, C); const int Rb = epi_perm2<Epi>::v ? (64 * (R >> 5) + perm32(R & 31)) : Epi::PERM ? ((R & ~31) + perm32(R & 31)) : R;
        voffA[i] = (unsigned)(R * K + C) * 2u; voffB[i] = (unsigned)(Rb * K + C) * 2u; }
    static_assert(!GATHER || SP2, "GATHER is wired into the SP2 loop only");
    int gR[2], gC[2];
#pragma unroll
    for (int i = 0; i < 2; ++i) stage_rc(tid * 16 + i * 8192, gR[i], gC[i]);
    unsigned cv[2][2], nv[2][2];
#define PG8_GVOFF(dst, ui_) do { if constexpr (GATHER) { _Pragma("unroll") for (int h_ = 0; h_ < 2; ++h_) _Pragma("unroll") for (int i_ = 0; i_ < 2; ++i_) \
        dst[h_][i_] = (unsigned)(S.rowt[(ui_) * 256 + 128 * h_ + gR[i_]] * K + gC[i_]) * 2u; } } while (0)
    const size_t kstep = (size_t)(BK * 2);
    const size_t hstep = (size_t)HALF * K * 2;
    const size_t hstepB = epi_perm2<Epi>::v ? (size_t)32 * K * 2 : hstep;
    const size_t tstep = 2 * hstep;
    const unsigned ldsw = (unsigned)wid * 1024u;
    const int aoff = lds_byte(wr * 64 + fr, fq * 8), boff = lds_byte(wc * 32 + fr, fq * 8);
#define PG8_SA(b, h) (((b) * 2 + (h)) * HTB)
#define PG8_SB(b, h) ((4 + (b) * 2 + (h)) * HTB)
#define PG8_STAGE(bufoff, gbase, voff) do { _Pragma("unroll") for (int _i = 0; _i < 2; ++_i) \
        __builtin_amdgcn_global_load_lds((const unsigned*)((const char*)(gbase) + (voff)[_i]), (PG8_LAS unsigned*)(lds + (bufoff) + ldsw + _i * 8192), 16, 0, 0); } while (0)
#define PG8_LDA(dst, b, h) do { _Pragma("unroll") for (int m = 0; m < 4; ++m) _Pragma("unroll") for (int k = 0; k < 2; ++k) dst[m][k] = *(const PG8_LAS bf16x8*)(lds + PG8_SA(b, h) + aoff + m * 2048 + k * 1024); } while (0)
#define PG8_LDB(dst, b, h) do { _Pragma("unroll") for (int n = 0; n < 2; ++n) _Pragma("unroll") for (int k = 0; k < 2; ++k) dst[n][k] = *(const PG8_LAS bf16x8*)(lds + PG8_SB(b, h) + boff + n * 2048 + k * 1024); } while (0)
#define PG8_MMA(ai, bj, At, Bt) do { __builtin_amdgcn_s_setprio(1); _Pragma("unroll") for (int m = 0; m < 4; ++m) _Pragma("unroll") for (int n = 0; n < 2; ++n) _Pragma("unroll") for (int k = 0; k < 2; ++k) \
        acc[ai][bj][m][n] = __builtin_amdgcn_mfma_f32_16x16x32_bf16(Bt[n][k], At[m][k], acc[ai][bj][m][n], 0, 0, 0); __builtin_amdgcn_s_setprio(0); } while (0)
#define PG8_WAIT_V(n) asm volatile("s_waitcnt vmcnt(" #n ")" ::: "memory")
#define PG8_WAIT_L(n) asm volatile("s_waitcnt lgkmcnt(" #n ")" ::: "memory")
#define PG8_BAR __builtin_amdgcn_s_barrier()
#define PG8_SCHED __builtin_amdgcn_sched_barrier(0)
    Unit cur, nxt; int ui = 0;
    if (!S.next(0, cur)) return;
    f32x4 acc[2][2][4][2];
#pragma unroll
    for (int a = 0; a < 2; ++a)
#pragma unroll
        for (int b = 0; b < 2; ++b)
#pragma unroll
            for (int m = 0; m < 4; ++m)
#pragma unroll
                for (int n = 0; n < 2; ++n) acc[a][b][m][n] = (f32x4){0.f, 0.f, 0.f, 0.f};
    bf16x8 At[4][2], B0[2][2], B1[2][2];
    const char* cA = (const char*)g.A + (GATHER ? (size_t)0 : (size_t)cur.pm * tstep); const char* cB = (const char*)g.Bt + (size_t)cur.pn * tstep;
    PG8_GVOFF(cv, 0);
#define PG8_STAGE_A(bufoff, kptr, h_, usenext) do { if constexpr (GATHER) { unsigned vs_[2]; vs_[0] = (usenext) ? nv[h_][0] : cv[h_][0]; vs_[1] = (usenext) ? nv[h_][1] : cv[h_][1]; PG8_STAGE(bufoff, kptr, vs_); } else PG8_STAGE(bufoff, (kptr) + (h_) * hstep, voffA); } while (0)
    S.a_ready(cur);
    if constexpr (SP2) {
        PG8_STAGE(PG8_SB(0, 0), cB, voffB); PG8_STAGE(PG8_SB(0, 1), cB + hstepB, voffB); PG8_STAGE_A(PG8_SA(0, 0), cA, 0, false); PG8_STAGE_A(PG8_SA(0, 1), cA, 1, false);
        if (wr == 1) PG8_BAR;
        PG8_WAIT_V(2); PG8_BAR;
        PG8_STAGE(PG8_SB(1, 0), cB + kstep, voffB); PG8_STAGE_A(PG8_SA(1, 0), cA + kstep, 0, false); PG8_STAGE(PG8_SB(1, 1), cB + hstepB + kstep, voffB);
        PG8_WAIT_V(6); PG8_BAR;
    } else {
        PG8_STAGE(PG8_SB(0, 0), cB, voffB); PG8_STAGE(PG8_SA(0, 0), cA, voffA); PG8_STAGE(PG8_SB(0, 1), cB + hstepB, voffB); PG8_STAGE(PG8_SA(0, 1), cA + hstep, voffA);
        if (wr == 1) PG8_BAR;
        PG8_WAIT_V(4); PG8_BAR;
        PG8_STAGE(PG8_SB(1, 0), cB + kstep, voffB); PG8_STAGE(PG8_SA(1, 0), cA + kstep, voffA); PG8_STAGE(PG8_SB(1, 1), cB + hstepB + kstep, voffB);
        PG8_WAIT_V(6); PG8_BAR;
    }
    for (;;) {
        const bool has_next = S.next(ui + 1, nxt);
        const char* nA = (has_next && !GATHER) ? (const char*)g.A + (size_t)nxt.pm * tstep : cA;
        if constexpr (GATHER) { if (has_next) PG8_GVOFF(nv, ui + 1); else { _Pragma("unroll") for (int h_ = 0; h_ < 2; ++h_) _Pragma("unroll") for (int i_ = 0; i_ < 2; ++i_) nv[h_][i_] = cv[h_][i_]; } } const char* nB = has_next ? (const char*)g.Bt + (size_t)nxt.pn * tstep : cB;
        for (int t = 0; t < nt; t += 2) {
            const bool last = (t == nt - 2);
            const char* a1 = cA + (size_t)(t + 1) * kstep;
            const char* a2 = last ? nA : cA + (size_t)(t + 2) * kstep; const char* b2 = last ? nB : cB + (size_t)(t + 2) * kstep;
            const char* a3 = a2 + kstep; const char* b3 = b2 + kstep;
            if (last && has_next) S.a_ready(nxt);
            if constexpr (SP2) {
            PG8_LDB(B0, 0, 0); PG8_LDB(B1, 0, 1); PG8_SCHED; PG8_LDA(At, 0, 0); PG8_STAGE_A(PG8_SA(1, 1), a1, 1, false);
            PG8_WAIT_V(8); PG8_WAIT_L(0); PG8_BAR; PG8_MMA(0, 0, At, B0); PG8_MMA(0, 1, At, B1); PG8_BAR; PG8_SCHED;
            PG8_LDA(At, 0, 1); PG8_STAGE(PG8_SB(0, 0), b2, voffB); PG8_STAGE(PG8_SB(0, 1), b2 + hstepB, voffB); PG8_STAGE_A(PG8_SA(0, 0), a2, 0, last);
            PG8_WAIT_V(8); PG8_WAIT_L(0); PG8_BAR; PG8_MMA(1, 0, At, B0); PG8_MMA(1, 1, At, B1); PG8_BAR; PG8_SCHED;
            PG8_LDB(B0, 1, 0); PG8_LDB(B1, 1, 1); PG8_SCHED; PG8_LDA(At, 1, 0); PG8_STAGE_A(PG8_SA(0, 1), a2, 1, last);
            PG8_WAIT_V(8); PG8_WAIT_L(0); PG8_BAR; PG8_MMA(0, 0, At, B0); PG8_MMA(0, 1, At, B1); PG8_BAR; PG8_SCHED;
            PG8_LDA(At, 1, 1); PG8_STAGE(PG8_SB(1, 0), b3, voffB); PG8_STAGE(PG8_SB(1, 1), b3 + hstepB, voffB); PG8_STAGE_A(PG8_SA(1, 0), a3, 0, last);
            PG8_WAIT_V(8); PG8_WAIT_L(0); PG8_BAR; PG8_MMA(1, 0, At, B0); PG8_MMA(1, 1, At, B1); PG8_BAR; PG8_SCHED;
            } else {
            PG8_LDB(B0, 0, 0); PG8_SCHED; PG8_LDA(At, 0, 0); PG8_STAGE(PG8_SA(1, 1), a1 + hstep, voffA);
            PG8_WAIT_L(8); PG8_BAR; PG8_WAIT_L(0); PG8_MMA(0, 0, At, B0); PG8_BAR; PG8_SCHED;
            PG8_LDB(B1, 0, 1); PG8_STAGE(PG8_SB(0, 0), b2, voffB);
            PG8_BAR; PG8_WAIT_L(0); PG8_MMA(0, 1, At, B1); PG8_BAR;
            PG8_LDA(At, 0, 1); PG8_STAGE(PG8_SA(0, 0), a2, voffA);
            PG8_BAR; PG8_WAIT_L(0); PG8_MMA(1, 0, At, B0); PG8_BAR; PG8_SCHED;
            PG8_STAGE(PG8_SB(0, 1), b2 + hstepB, voffB);
            PG8_WAIT_V(6); PG8_BAR; PG8_MMA(1, 1, At, B1); PG8_BAR;
            PG8_LDB(B0, 1, 0); PG8_SCHED; PG8_LDA(At, 1, 0); PG8_STAGE(PG8_SA(0, 1), a2 + hstep, voffA);
            PG8_WAIT_L(8); PG8_BAR; PG8_WAIT_L(0); PG8_MMA(0, 0, At, B0); PG8_BAR; PG8_SCHED;
            PG8_LDB(B1, 1, 1); PG8_STAGE(PG8_SB(1, 0), b3, voffB);
            PG8_BAR; PG8_WAIT_L(0); PG8_MMA(0, 1, At, B1); PG8_BAR;
            PG8_LDA(At, 1, 1); PG8_STAGE(PG8_SA(1, 0), a3, voffA);
            PG8_BAR; PG8_WAIT_L(0); PG8_MMA(1, 0, At, B0); PG8_BAR; PG8_SCHED;
            PG8_STAGE(PG8_SB(1, 1), b3 + hstepB, voffB);
            PG8_WAIT_V(6); PG8_BAR; PG8_MMA(1, 1, At, B1); PG8_BAR;
            }
        }
        if constexpr (ALIGN_EPI) { if (wr == 0) PG8_BAR; }
        if constexpr (!Epi::AFTER_DRAIN) { E(acc, cur, wr, wc, fr, fq); S.done(cur); }
        if (!has_next) break;
#pragma unroll
        for (int a = 0; a < 2; ++a)
#pragma unroll
            for (int b = 0; b < 2; ++b)
#pragma unroll
                for (int m = 0; m < 4; ++m)
#pragma unroll
                    for (int n = 0; n < 2; ++n) acc[a][b][m][n] = (f32x4){0.f, 0.f, 0.f, 0.f};
        cur = nxt; cA = nA; cB = nB; ++ui;
        if constexpr (GATHER) { _Pragma("unroll") for (int h_ = 0; h_ < 2; ++h_) _Pragma("unroll") for (int i_ = 0; i_ < 2; ++i_) cv[h_][i_] = nv[h_][i_]; }
        if constexpr (ALIGN_EPI) { if (wr == 1) PG8_BAR; }
    }
    PG8_WAIT_V(0);
    if constexpr (!ALIGN_EPI) { if (wr == 0) PG8_BAR; }
    PG8_BAR;
    if constexpr (Epi::AFTER_DRAIN) { E.fused(acc, cur, wr, wc, fr, fq, lds, wid, lane); S.done(cur); }
#undef PG8_SA
#undef PG8_SB
#undef PG8_STAGE
#undef PG8_STAGE_A
#undef PG8_GVOFF
#undef PG8_LDA
#undef PG8_LDB
#undef PG8_MMA
#undef PG8_WAIT_V
#undef PG8_WAIT_L
#undef PG8_BAR
#undef PG8_SCHED
}
}
#define XB_TMO      128
#define XB_XCNT(j)  (256  + 64 * (j))
#define XB_XSUB(j)  (1280 + 64 * (j))
#define XB_XGEN(j)  (2304 + 64 * (j))
#define XB_TOP      3328
#define XB_TOPGEN   3392
#define XCD_BAR_WORDS 3456
#define XB_SPIN_CAP (1u << 18)

__device__ __forceinline__ unsigned xb_ld(unsigned* p)              { return __hip_atomic_load(p, __ATOMIC_RELAXED, __HIP_MEMORY_SCOPE_AGENT); }
__device__ __forceinline__ unsigned xb_add(unsigned* p, unsigned v) { return __hip_atomic_fetch_add(p, v, __ATOMIC_RELAXED, __HIP_MEMORY_SCOPE_AGENT); }
__device__ __forceinline__ unsigned xb_xcc_id() { return (unsigned)__builtin_amdgcn_s_getreg((3 << 11) | 20) & 0xFu; }
#define XB_SPIN(cond, bar) do { unsigned _sp = 0; while (cond) { __builtin_amdgcn_s_sleep(1); \
    if ((++_sp & 255u) == 0u) { if (xb_ld(&(bar)[XB_TMO])) break; if (_sp > XB_SPIN_CAP) { atomicAdd(&(bar)[XB_TMO], 1u); break; } } } } while (0)

struct XcdBarrier {
    unsigned* bar; unsigned x;
    volatile LAS unsigned* st;
};

__device__ __forceinline__ XcdBarrier xcd_barrier_post(unsigned* bar, volatile LAS unsigned* st) {
    XcdBarrier b; b.bar = bar; b.x = xb_xcc_id(); b.st = st;
    if (threadIdx.x == 0) (void)xb_add(&bar[XB_XCNT(b.x)], 1u);
    return b;
}
__device__ __forceinline__ void xcd_barrier_complete(unsigned* bar, unsigned x, unsigned& nloc, unsigned& nx) {
    const unsigned G = gridDim.x * gridDim.y * gridDim.z;
    unsigned sum, cnt, mine, sp = 0u;
    for (;;) {
        sum = 0u; cnt = 0u; mine = 0u;
#pragma unroll
        for (unsigned j = 0; j < 16; ++j) { const unsigned c = xb_ld(&bar[XB_XCNT(j)]); sum += c; cnt += (c > 0u) ? 1u : 0u; mine = (j == x) ? c : mine; }
        if (sum == G) break;
        __builtin_amdgcn_s_sleep(1);
        if ((++sp & 255u) == 0u) { if (xb_ld(&bar[XB_TMO])) break; if (sp > XB_SPIN_CAP) { atomicAdd(&bar[XB_TMO], 1u); break; } }
    }
    nloc = mine > 0u ? mine : 1u; nx = cnt > 0u ? cnt : 1u;
}

__device__ __forceinline__ void xcd_barrier(const XcdBarrier& b) {
    asm volatile("s_waitcnt vmcnt(0)" ::: "memory");
    __syncthreads();
    if (threadIdx.x == 0) {
        unsigned* bar = b.bar;
        __builtin_amdgcn_s_waitcnt(0);
        unsigned nloc = b.st[0], nx = b.st[1];
        if (nloc == 0u) { xcd_barrier_complete(bar, b.x, nloc, nx); b.st[0] = nloc; b.st[1] = nx; }
        const unsigned old = xb_add(&bar[XB_XSUB(b.x)], 1u);
        const unsigned gen = old / nloc;
        if (old + 1u == (gen + 1u) * nloc) {
            __builtin_amdgcn_fence(__ATOMIC_RELEASE, "agent");
            asm volatile("s_waitcnt vmcnt(0)" ::: "memory");
            const unsigned og = xb_add(&bar[XB_TOP], 1u);
            const unsigned tg = og / nx;
            if (og + 1u == (tg + 1u) * nx) xb_add(&bar[XB_TOPGEN], 1u);
            else XB_SPIN(xb_ld(&bar[XB_TOPGEN]) == tg, bar);
            __builtin_amdgcn_fence(__ATOMIC_ACQUIRE, "agent");
            xb_add(&bar[XB_XGEN(b.x)], 1u);
            asm volatile("s_waitcnt vmcnt(0)" ::: "memory");
        } else {
            XB_SPIN(xb_ld(&bar[XB_XGEN(b.x)]) == gen, bar);
            __builtin_amdgcn_fence(__ATOMIC_ACQUIRE, "agent");
            asm volatile("s_waitcnt vmcnt(0)" ::: "memory");
        }
    }
    __syncthreads();
}
constexpr int NB = 4, S = 8192, D = 1024, M = NB * S, NIN = 11520, NL = 2, NE = 32;
constexpr int C_LRUX = 0, C_LRUG = 1024, C_Q = 2048, C_K = 3072, C_V = 4096, C_RW = 5120, C_GATE = 8448;
constexpr int NSLOT_MAX = (M * 4 / 256 + NE) * 256;
constexpr size_t MiB = 1u << 20;
constexpr size_t WS_CTL = 0, CTL_ZERO_BYTES = 1 * MiB;
constexpr size_t WS_ADA = 1 * MiB;
constexpr size_t WS_SUMM = 2 * MiB;
constexpr size_t WS_TOPE = 4 * MiB, WS_TOPW = 4 * MiB + 512 * 1024, WS_TSLOT = 5 * MiB;
constexpr size_t WS_STOK = 10 * MiB;
constexpr size_t WS_TRAW = 5 * MiB + 512 * 1024;
constexpr size_t WS_CARRY = 9 * MiB;
constexpr size_t WS_WAT = 6 * MiB, WS_WXT = 6 * MiB + 128 * 1024, WS_LORAB = 7 * MiB;
constexpr size_t WS_WIN = 16 * MiB, WS_PT = 39 * MiB, WS_WOUT = 45 * MiB, WS_WGU = 48 * MiB, WS_WD = 176 * MiB;
constexpr size_t WS_X1 = 240 * MiB, WS_X2 = 368 * MiB, WS_H = 496 * MiB;
constexpr size_t WS_COLS = 560 * MiB;
constexpr size_t WS_KK = 1280 * MiB, WS_BB = 1344 * MiB, WS_KP = 1408 * MiB, WS_R = 1472 * MiB, WS_OM = 1536 * MiB, WS_V = 1600 * MiB, WS_G = 1664 * MiB;
constexpr size_t WS_YA = 1728 * MiB, WS_YB = 1792 * MiB, WS_YC = 1856 * MiB, WS_VT = 1920 * MiB, WS_AP = 1984 * MiB, WS_END = 2000 * MiB;
constexpr size_t WS_XG = 560 * MiB, WS_ACT = 832 * MiB, WS_YBUF = 1104 * MiB;
static_assert(WS_YBUF + (size_t)NSLOT_MAX * 1024 * 2 <= WS_G, "MoE overlay");
constexpr int CW_TMO = 0, CW_BAR = 4096, CW_CNT = 8192, CW_CUR = 8448, CW_CVT = 8704;
constexpr int LDS_BYTES = 163840, TAB_OFF = 131072, ROWT_OFF = TAB_OFF + 4096, MISC_OFF = LDS_BYTES - 256;
constexpr int N_PHASES = 28;
#ifndef MK_PER_PHASE
#define MK_PER_PHASE 0
#endif

#define DI __device__ __forceinline__
#define LDS_WAIT() asm volatile("s_waitcnt lgkmcnt(0)" ::: "memory")
typedef unsigned short bf16;
typedef unsigned u32x4 __attribute__((ext_vector_type(4)));
typedef unsigned u32x2 __attribute__((ext_vector_type(2)));
typedef float f32x4 __attribute__((ext_vector_type(4)));
typedef float f32x16 __attribute__((ext_vector_type(16)));
typedef short bf16x8 __attribute__((ext_vector_type(8)));
using pg8::bflo; using pg8::bfhi; using pg8::sigm; using pg8::frcp; using pg8::f32x2c;
DI unsigned cvtpk(float lo, float hi) { return pg8::cvt_pk_bf16(lo, hi); }
DI float bf2f(bf16 b) { return __uint_as_float(((unsigned)b) << 16); }
DI bf16 f2bf(float f) { return (bf16)(cvtpk(f, 0.f) & 0xffffu); }
DI f32x4 load4bf(const bf16* p) { const u32x2 w = *(const u32x2*)p; return (f32x4){bflo(w.x), bfhi(w.x), bflo(w.y), bfhi(w.y)}; }
DI void store4bf(bf16* p, f32x4 v) { u32x2 w; w.x = cvtpk(v.x, v.y); w.y = cvtpk(v.z, v.w); *(u32x2*)p = w; }
#define SHX(v, m) __builtin_bit_cast(float, __builtin_amdgcn_ds_bpermute(((lane) ^ (m)) << 2, __builtin_bit_cast(int, (float)(v))))
#define SHXI(v, m) __builtin_amdgcn_ds_bpermute(((lane) ^ (m)) << 2, (int)(v))
#define SHUP(v, d) __builtin_bit_cast(float, __builtin_amdgcn_ds_bpermute(((lane) - (d)) << 2, __builtin_bit_cast(int, (float)(v))))
#define SHLANE(v, src) __builtin_bit_cast(float, __builtin_amdgcn_ds_bpermute((src) << 2, __builtin_bit_cast(int, (float)(v))))
DI float wave_sum(float v, int lane) {
    (void)lane;
#define DPPF_(ctrl_, rm_, bc_) __builtin_bit_cast(float, __builtin_amdgcn_update_dpp(0, __builtin_bit_cast(int, v), ctrl_, rm_, 0xf, bc_))
    v += DPPF_(0x111, 0xf, true); v += DPPF_(0x112, 0xf, true); v += DPPF_(0x114, 0xf, true); v += DPPF_(0x118, 0xf, true); v += DPPF_(0x142, 0xa, false); v += DPPF_(0x143, 0xc, false);
#undef DPPF_
    return __builtin_bit_cast(float, __builtin_amdgcn_readlane(__builtin_bit_cast(int, v), 63));
}
DI float grp16_sum(float v, int lane) { v += SHX(v, 1); v += SHX(v, 2); v += SHX(v, 4); v += SHX(v, 8); return v; }
DI float fexp2(float x) { return __builtin_amdgcn_exp2f(x); }
DI float flog2(float x) { return __builtin_amdgcn_logf(x); }
#define MFMA32(a, b, c) __builtin_amdgcn_mfma_f32_32x32x16_bf16((a), (b), (c), 0, 0, 0)
#define MFMA16(a, b, c) __builtin_amdgcn_mfma_f32_16x16x32_bf16((a), (b), (c), 0, 0, 0)
DI u32x4 zero4() { unsigned z; asm volatile("v_mov_b32 %0, 0" : "=v"(z)); return (u32x4){z, z, z, z}; }
DI int crow(int reg, int h) { return (reg & 3) + 8 * (reg >> 2) + 4 * h; }

struct Args { const float* in[36]; float* out; unsigned char* ws; int ph_lo, ph_hi, li, pad; };
struct PA { const float* const* in; float* out; unsigned char* ws; };
enum { I_X = 0, I_C, I_WADA, I_BADA, I_NMIX, I_NMOE, I_NFIN, I_WIN, I_CONVW, I_CONVB, I_WA, I_BA, I_WX, I_BX, I_LAM, I_MU, I_W0, I_WUP, I_A0, I_AUP, I_GUP, I_KK, I_KA, I_RK,
       I_LNW, I_LNB, I_PLRU, I_PSB, I_PRW, I_WOUT, I_WR, I_BR, I_WGU, I_BGU, I_WDN, I_BDN };

DI void ph_ada(const PA& a, LAS unsigned char* lds, int tid, int lane, int gw, int NGW) {
    LAS float* ca = (LAS float*)lds;
    LAS float* part = (LAS float*)(lds + 16384);
    for (int i = tid; i < 4096; i += 512) { const float c = a.in[I_C][i]; ca[i] = c * sigm(c); }
    __syncthreads();
    float* ADA = (float*)(a.ws + WS_ADA); const int wave = tid >> 6;
    for (int u = blockIdx.x; u < NL * 96; u += gridDim.x) {
        const int l = u / 96, col = (u % 96) * 64 + lane;
        const float* w = a.in[I_WADA] + (size_t)l * 1024 * 6144 + col;
        float a0 = 0.f, a1 = 0.f, a2 = 0.f, a3 = 0.f;
#pragma unroll 16
        for (int k = wave * 128; k < wave * 128 + 128; ++k) { const float wv = w[(size_t)k * 6144]; a0 += ca[k] * wv; a1 += ca[1024 + k] * wv; a2 += ca[2048 + k] * wv; a3 += ca[3072 + k] * wv; }
        part[(wave * 4 + 0) * 64 + lane] = a0; part[(wave * 4 + 1) * 64 + lane] = a1; part[(wave * 4 + 2) * 64 + lane] = a2; part[(wave * 4 + 3) * 64 + lane] = a3;
        __syncthreads();
        if (wave < 4) { float sacc = 0.f;
#pragma unroll
            for (int q = 0; q < 8; ++q) sacc += part[(q * 4 + wave) * 64 + lane];
            ADA[(l * 4 + wave) * 6144 + col] = sacc + a.in[I_BADA][l * 6144 + col]; }
        __syncthreads();
    }
}

DI void tr_item(const float* __restrict__ W, int N, int k0, int n0, bf16* WT, int ldk, int drow0, int dk, LAS float* scr, int lane) {
#pragma unroll
    for (int i = 0; i < 8; ++i) { const int kk = 8 * i + (lane >> 3); const f32x4 v = *(const f32x4*)(W + (size_t)(k0 + kk) * N + n0 + 4 * (lane & 7));
        LAS float* s = scr + kk * 33 + 4 * (lane & 7); s[0] = v.x; s[1] = v.y; s[2] = v.z; s[3] = v.w; }
    LDS_WAIT();
    const int c = lane & 7;
#pragma unroll
    for (int j = 0; j < 4; ++j) { const int n = (lane >> 3) + 8 * j; const LAS float* s = scr + (8 * c) * 33 + n;
        u32x4 o; o.x = cvtpk(s[0 * 33], s[1 * 33]); o.y = cvtpk(s[2 * 33], s[3 * 33]); o.z = cvtpk(s[4 * 33], s[5 * 33]); o.w = cvtpk(s[6 * 33], s[7 * 33]);
        *(u32x4*)(WT + (size_t)(drow0 + n) * ldk + dk + 8 * c) = o; }
    LDS_WAIT();
}
constexpr int CVT_EXPERT_ITEMS = 32768 + 16384;
DI void convert_expert_item(const PA& a, int l, int it, LAS float* scr, int lane) {
    unsigned char* ws = a.ws; bf16* WguT = (bf16*)(ws + WS_WGU); bf16* WdT = (bf16*)(ws + WS_WD);
    if (it < 32768) { const int e = it / 1024, r2 = it % 1024, kb = r2 / 64, nb = r2 % 64, n0 = 32 * nb;
        const int drow = e * 2048 + (n0 < 1024 ? 256 * (n0 / 128) + (n0 % 128) : 256 * ((n0 - 1024) / 128) + 128 + ((n0 - 1024) % 128));
        tr_item(a.in[I_WGU] + ((size_t)l * NE + e) * 1024 * 2048, 2048, 64 * kb, n0, WguT, 1024, drow, 64 * kb, scr, lane); }
    else { const int r = it - 32768, e = r / 512, r2 = r % 512, kb = r2 / 32, nb = r2 % 32;
        tr_item(a.in[I_WDN] + ((size_t)l * NE + e) * 1024 * 1024, 1024, 64 * kb, 32 * nb, WdT, 1024, e * 1024 + 32 * nb, 64 * kb, scr, lane); }
}
DI void cvt_item_decode(const PA& a, int l, int it, const float*& src, int& N, int& k0, int& n0, bf16*& dst, int& drow) {
    unsigned char* ws = a.ws;
    if (it < 32768) { const int e = it / 1024, r2 = it % 1024, kb = r2 / 64, nb = r2 % 64; n0 = 32 * nb; k0 = 64 * kb; N = 2048;
        drow = e * 2048 + (n0 < 1024 ? 256 * (n0 / 128) + (n0 % 128) : 256 * ((n0 - 1024) / 128) + 128 + ((n0 - 1024) % 128));
        src = a.in[I_WGU] + ((size_t)l * NE + e) * 1024 * 2048; dst = (bf16*)(ws + WS_WGU); }
    else { const int r = it - 32768, e = r / 512, r2 = r % 512, kb = r2 / 32, nb = r2 % 32; n0 = 32 * nb; k0 = 64 * kb; N = 1024;
        drow = e * 1024 + n0; src = a.in[I_WDN] + ((size_t)l * NE + e) * 1024 * 1024; dst = (bf16*)(ws + WS_WD); }
}
DI void cvt_item_load(const PA& a, int l, int it, int lane, f32x4 (&v)[8]) {
    const float* src; int N, k0, n0, drow; bf16* dst; cvt_item_decode(a, l, it, src, N, k0, n0, dst, drow);
#pragma unroll
    for (int i = 0; i < 8; ++i) v[i] = *(const f32x4*)(src + (size_t)(k0 + 8 * i + (lane >> 3)) * N + n0 + 4 * (lane & 7));
}
DI void cvt_item_finish(const PA& a, int l, int it, int lane, const f32x4 (&v)[8], LAS float* scr) {
    const float* src; int N, k0, n0, drow; bf16* dst; cvt_item_decode(a, l, it, src, N, k0, n0, dst, drow);
#pragma unroll
    for (int i = 0; i < 8; ++i) { LAS float* s = scr + (8 * i + (lane >> 3)) * 33 + 4 * (lane & 7); s[0] = v[i].x; s[1] = v[i].y; s[2] = v[i].z; s[3] = v[i].w; }
    LDS_WAIT();
    const int c = lane & 7;
#pragma unroll
    for (int j = 0; j < 4; ++j) { const int n = (lane >> 3) + 8 * j; const LAS float* s = scr + (8 * c) * 33 + n;
        u32x4 o; o.x = cvtpk(s[0 * 33], s[1 * 33]); o.y = cvtpk(s[2 * 33], s[3 * 33]); o.z = cvtpk(s[4 * 33], s[5 * 33]); o.w = cvtpk(s[6 * 33], s[7 * 33]);
        *(u32x4*)(dst + (size_t)(drow + n) * 1024 + k0 + 8 * c) = o; }
    LDS_WAIT();
}
DI void convert_expert_queue(const PA& a, int l, LAS float* scr, int lane) {
    unsigned* ctr = (unsigned*)(a.ws + WS_CTL) + CW_CVT + 64 * l;
    for (;;) { unsigned it = 0; if (lane == 0) it = __hip_atomic_fetch_add(ctr, 16u, __ATOMIC_RELAXED, __HIP_MEMORY_SCOPE_AGENT);
        it = (unsigned)__builtin_amdgcn_readfirstlane((int)it); if (it >= (unsigned)CVT_EXPERT_ITEMS) break;
#pragma nounroll
        for (int q = 0; q < 16; ++q) convert_expert_item(a, l, (int)it + q, scr, lane); }
}
DI void ph_convert(const PA& a, int l, LAS unsigned char* lds, int tid, int lane, int wave, int gw, int NGW) {
    LAS float* scr = (LAS float*)(lds + wave * 16384);
    unsigned char* ws = a.ws;
    bf16* WinT = (bf16*)(ws + WS_WIN); bf16* PT = (bf16*)(ws + WS_PT); bf16* WoT = (bf16*)(ws + WS_WOUT); bf16* WguT = (bf16*)(ws + WS_WGU); bf16* WdT = (bf16*)(ws + WS_WD);
    bf16* WaT = (bf16*)(ws + WS_WAT); bf16* WxT = (bf16*)(ws + WS_WXT); bf16* LB = (bf16*)(ws + WS_LORAB);
    constexpr int I0 = 5760, I1 = I0 + 1536, I2 = I1 + 512, I3 = I2, I4 = I3, I5 = I4 + 32, I6 = I5 + 32, I7 = I6 + 32, I8 = I7 + 32, I9 = I8 + 64;
    for (int it = gw; it < I9; it += NGW) {
        if (it < I0) { const int kb = it / 360, nb = it % 360; tr_item(a.in[I_WIN] + (size_t)l * 1024 * NIN, NIN, 64 * kb, 32 * nb, WinT, 1024, 32 * nb, 64 * kb, scr, lane); }
        else if (it < I1) { const int r = it - I0, br = r / 512, r2 = r % 512, kb = r2 / 32, nb = r2 % 32;
            const float* src = (br == 0 ? a.in[I_PLRU] : br == 1 ? a.in[I_PSB] : a.in[I_PRW]) + (size_t)l * 1024 * 1024;
            tr_item(src, 1024, 64 * kb, 32 * nb, PT + (size_t)br * 1024 * 1024, 1024, 32 * nb, 64 * kb, scr, lane); }
        else if (it < I2) { const int r = it - I1, kb = r / 32, nb = r % 32; tr_item(a.in[I_WOUT] + (size_t)l * 1024 * 1024, 1024, 64 * kb, 32 * nb, WoT, 1024, 32 * nb, 64 * kb, scr, lane); }
        else if (it < I3) { const int r = it - I2, e = r / 1024, r2 = r % 1024, kb = r2 / 64, nb = r2 % 64, n0 = 32 * nb;
            const int drow = e * 2048 + (n0 < 1024 ? 256 * (n0 / 128) + (n0 % 128) : 256 * ((n0 - 1024) / 128) + 128 + ((n0 - 1024) % 128));
            tr_item(a.in[I_WGU] + ((size_t)l * NE + e) * 1024 * 2048, 2048, 64 * kb, n0, WguT, 1024, drow, 64 * kb, scr, lane); }
        else if (it < I4) { const int r = it - I3, e = r / 512, r2 = r % 512, kb = r2 / 32, nb = r2 % 32;
            tr_item(a.in[I_WDN] + ((size_t)l * NE + e) * 1024 * 1024, 1024, 64 * kb, 32 * nb, WdT, 1024, e * 1024 + 32 * nb, 64 * kb, scr, lane); }
        else if (it < I5) { const int r = it - I4, n = r / 2, nb = r % 2; tr_item(a.in[I_WA] + ((size_t)l * 16 + n) * 4096, 64, 0, 32 * nb, WaT, 64, n * 64 + 32 * nb, 0, scr, lane); }
        else if (it < I6) { const int r = it - I5, n = r / 2, nb = r % 2; tr_item(a.in[I_WX] + ((size_t)l * 16 + n) * 4096, 64, 0, 32 * nb, WxT, 64, n * 64 + 32 * nb, 0, scr, lane); }
        else if (it < I7) { const int nb = it - I6; tr_item(a.in[I_WUP] + (size_t)l * 64 * 1024, 1024, 0, 32 * nb, LB, 256, 32 * nb, 0, scr, lane); }
        else if (it < I8) { const int nb = it - I7; tr_item(a.in[I_AUP] + (size_t)l * 64 * 1024, 1024, 0, 32 * nb, LB, 256, 1024 + 32 * nb, 64, scr, lane); }
        else { const int r = it - I8, kb = r / 32, nb = r % 32; tr_item(a.in[I_GUP] + (size_t)l * 128 * 1024, 1024, 64 * kb, 32 * nb, LB, 256, 2048 + 32 * nb, 128 + 64 * kb, scr, lane); }
    }
    for (int idx = blockIdx.x * 512 + tid; idx < 3072 * 32; idx += NGW * 64) { const int row = idx >> 5, ch = idx & 31, sec = row >> 10;
        const bool nz = (sec == 0) ? (ch < 8) : (sec == 1) ? (ch >= 8 && ch < 16) : (ch >= 16);
        if (!nz) *(u32x4*)(LB + (size_t)row * 256 + 8 * ch) = zero4(); }
}

DI void ph_norm(const PA& a, int l, int mode, int lane, int gw) {
    unsigned char* ws = a.ws; const float* ADA = (const float*)(ws + WS_ADA);
    const bf16* x1 = (const bf16*)(ws + WS_X1); bf16* x2 = (bf16*)(ws + WS_X2); bf16* H = (bf16*)(ws + WS_H);
    const int* tslot = (const int*)(ws + WS_TSLOT); const float* topw = (const float*)(ws + WS_TOPW); const bf16* ybuf = (const bf16*)(ws + WS_YBUF);
    const float* gain = (mode == 2) ? a.in[I_NFIN] : a.in[I_NMIX] + l * 1024;
    f32x4 nx[4];
    if (mode == 0) {
#pragma unroll
        for (int j = 0; j < 4; ++j) nx[j] = *(const f32x4*)(a.in[I_X] + (size_t)(gw * 16) * 1024 + 4 * lane + 256 * j); }
    u32x2 yc[4][4], xc[4], yn[4][4], xn[4]; int sl[4]; float wc[4], wn[4];
#define NORM_ROWS(yb_, xr_, m_, s_) do { _Pragma("unroll") for (int j_ = 0; j_ < 4; ++j_) { const int col_ = 4 * lane + 256 * j_; xr_[j_] = *(const u32x2*)(x1 + (size_t)(m_) * 1024 + col_); \
        _Pragma("unroll") for (int q_ = 0; q_ < 4; ++q_) yb_[q_][j_] = *(const u32x2*)(ybuf + (size_t)s_[q_] * 1024 + col_); } } while (0)
    if (mode != 0) { const int mf = gw * 16;
#pragma unroll
        for (int q = 0; q < 4; ++q) { sl[q] = tslot[mf * 4 + q]; wc[q] = topw[mf * 4 + q]; }
        NORM_ROWS(yc, xc, mf, sl);
#pragma unroll
        for (int q = 0; q < 4; ++q) { sl[q] = tslot[(mf + 1) * 4 + q]; wn[q] = topw[(mf + 1) * 4 + q]; } }
#pragma nounroll
    for (int i = 0; i < 16; ++i) {
        const int m = gw * 16 + i, b = m >> 13;
        f32x4 v[4];
        if (mode == 0) {
#pragma unroll
            for (int j = 0; j < 4; ++j) v[j] = nx[j];
            const int mn = (i + 1 < 16) ? m + 1 : m;
#pragma unroll
            for (int j = 0; j < 4; ++j) nx[j] = *(const f32x4*)(a.in[I_X] + (size_t)mn * 1024 + 4 * lane + 256 * j);
        } else {
            const int lp = (mode == 2) ? NL - 1 : l - 1; const float* gffn = ADA + (lp * 4 + b) * 6144 + 5120;
            const int m1 = (i + 1 < 16) ? m + 1 : m, m2 = (i + 2 < 16) ? m + 2 : m;
            NORM_ROWS(yn, xn, m1, sl);
            float wnn[4];
#pragma unroll
            for (int q = 0; q < 4; ++q) { sl[q] = tslot[m2 * 4 + q]; wnn[q] = topw[m2 * 4 + q]; }
#pragma unroll
            for (int j = 0; j < 4; ++j) { const int col = 4 * lane + 256 * j;
#define UB(w_) ((f32x4){bflo(w_.x), bfhi(w_.x), bflo(w_.y), bfhi(w_.y)})
                f32x4 acc = wc[0] * UB(yc[0][j]); acc += wc[1] * UB(yc[1][j]); acc += wc[2] * UB(yc[2][j]); acc += wc[3] * UB(yc[3][j]);
                v[j] = UB(xc[j]) + *(const f32x4*)(gffn + col) * acc;
#undef UB
                if (mode == 1) store4bf(x2 + (size_t)m * 1024 + col, v[j]); }
#pragma unroll
            for (int q = 0; q < 4; ++q) { wc[q] = wn[q]; wn[q] = wnn[q]; }
        }
        float ss = 0.f;
#pragma unroll
        for (int j = 0; j < 4; ++j) ss += (v[j].x * v[j].x + v[j].y * v[j].y) + (v[j].z * v[j].z + v[j].w * v[j].w);
        const float rstd = 1.0f / sqrtf(wave_sum(ss, lane) * (1.0f / 1024.0f) + 1e-6f);
#pragma unroll
        for (int j = 0; j < 4; ++j) { const int col = 4 * lane + 256 * j; const f32x4 gn = *(const f32x4*)(gain + col);
            if (mode == 2) *(f32x4*)(a.out + (size_t)m * 1024 + col) = v[j] * rstd * gn;
            else { const f32x4 sh = *(const f32x4*)(ADA + (l * 4 + b) * 6144 + col), sc = *(const f32x4*)(ADA + (l * 4 + b) * 6144 + 1024 + col);
                store4bf(H + (size_t)m * 1024 + col, v[j] * rstd * gn * (1.0f + sc) + sh); } }
        if (mode != 0) {
#pragma unroll
            for (int j = 0; j < 4; ++j) { xc[j] = xn[j];
#pragma unroll
                for (int q = 0; q < 4; ++q) yc[q][j] = yn[q][j]; } }
    }
#undef NORM_ROWS
}

template <int K0, int K1> DI void rw_prep_load(const bf16* cols, int m, int lane, u32x2 (&d)[7]) {
    const bf16* base = cols + (size_t)m * NIN + C_RW + 4 * lane;
#pragma unroll
    for (int k = K0; k < K1; ++k) d[k - K0] = *(const u32x2*)(base + 256 * k);
}
template <int K0, int K1> DI void rw_prep_row(const PA& a, int l, int m, int lane, LAS u32x2* pl, const u32x2 (&cur)[7]) {
    unsigned char* ws = a.ws;
    bf16* KK = (bf16*)(ws + WS_KK); bf16* KP = (bf16*)(ws + WS_KP); bf16* R = (bf16*)(ws + WS_R); bf16* V = (bf16*)(ws + WS_V); bf16* AP = (bf16*)(ws + WS_AP);
    int zq; asm volatile("s_mov_b32 %0, 0" : "=s"(zq));
    const float* mu = a.in[I_MU] + l * 3328 + zq; const float* kkw = a.in[I_KK] + l * 1024 + zq;
#pragma unroll
    for (int k = K0; k < K1; ++k) { const u32x2 ck = cur[k - K0], pk = pl[64 * k]; pl[64 * k] = ck;
        const f32x4 xc = (f32x4){bflo(ck.x), bfhi(ck.x), bflo(ck.y), bfhi(ck.y)}, xp = (f32x4){bflo(pk.x), bfhi(pk.x), bflo(pk.y), bfhi(pk.y)};
        if (k < 12) { const int sec = k >> 2, col = 256 * (k & 3) + 4 * lane, cc = 1024 * sec + col;
            const f32x4 xs = xc + *(const f32x4*)(mu + cc) * (xp - xc);
            if (sec == 0) store4bf(R + (size_t)m * 1024 + col, xs);
            else if (sec == 2) store4bf(V + (size_t)m * 1024 + col, xs);
            else { store4bf(KP + (size_t)m * 1024 + col, xs);
                const f32x4 kv = xs * *(const f32x4*)(kkw + col);
                const float ssq = grp16_sum((kv.x * kv.x + kv.y * kv.y) + (kv.z * kv.z + kv.w * kv.w), lane);
                const float inv = 1.0f / fmaxf(sqrtf(ssq), 1e-12f);
                store4bf(KK + (size_t)m * 1024 + col, kv * inv); } }
        else { const int cc = 3072 + 4 * lane;
            const f32x4 xs = xc + *(const f32x4*)(mu + cc) * (xp - xc); f32x4 o;
            if (lane < 16) { o.x = 1.0f - 2.0f * frcp(__expf(2.0f * xs.x) + 1.0f); o.y = 1.0f - 2.0f * frcp(__expf(2.0f * xs.y) + 1.0f); o.z = 1.0f - 2.0f * frcp(__expf(2.0f * xs.z) + 1.0f); o.w = 1.0f - 2.0f * frcp(__expf(2.0f * xs.w) + 1.0f); }
            else if (lane < 32) o = xs;
            else { o.x = sigm(xs.x); o.y = sigm(xs.y); o.z = sigm(xs.z); o.w = sigm(xs.w); }
            store4bf(AP + (size_t)m * 256 + 4 * lane, o); } }
}
DI float gelu_tanh(float x) { const float u = 0.7978845608f * (x + 0.044715f * x * x * x); const float t = 1.0f - 2.0f * frcp(__expf(2.0f * u) + 1.0f); return 0.5f * x * (1.0f + t); }
DI void lru_phase(const PA& a, int l, LAS unsigned char* lds, int tid, int lane, int wave, int prep_m0 = -1) {
    LAS bf16* XS = (LAS bf16*)lds;
    LAS bf16* XA = (LAS bf16*)(lds + 16896);
    LAS float* AA = (LAS float*)(lds + 35328);
    LAS float* BBv = (LAS float*)(lds + 68096);
    LAS float* SEG = (LAS float*)(lds + 100864);
    unsigned char* ws = a.ws; const bf16* cols = (const bf16*)(ws + WS_COLS); float* summ = (float*)(ws + WS_SUMM); bf16* HL = (bf16*)(ws + WS_YA); bf16* PT = (bf16*)(ws + WS_H);
    const bf16* WaT = (const bf16*)(ws + WS_WAT); const bf16* WxT = (const bf16*)(ws + WS_WXT);
    const int n = blockIdx.x & 15, p0 = blockIdx.x >> 4;
    const int fr = lane & 15, fq = lane >> 4, c = tid & 63, seg = tid >> 6;
    bf16x8 wa[4][2], wx[4][2]; float ba[4], bx[4], spl[4];
#pragma unroll
    for (int ct = 0; ct < 4; ++ct) { const bf16* pa = WaT + (size_t)(n * 64 + 16 * ct + fr) * 64 + 8 * fq; const bf16* px = WxT + (size_t)(n * 64 + 16 * ct + fr) * 64 + 8 * fq;
        wa[ct][0] = *(const bf16x8*)pa; wa[ct][1] = *(const bf16x8*)(pa + 32); wx[ct][0] = *(const bf16x8*)px; wx[ct][1] = *(const bf16x8*)(px + 32);
        const int ch = 64 * n + 16 * ct + fr; ba[ct] = a.in[I_BA][l * 1024 + ch]; bx[ct] = a.in[I_BX][l * 1024 + ch]; const float lam = a.in[I_LAM][l * 1024 + ch];
        spl[ct] = fmaxf(-lam, 0.f) + __logf(1.0f + __expf(-fabsf(lam))); }
    const float* cw = a.in[I_CONVW] + (size_t)l * 4 * 1024 + 64 * n + c;
    const float w0 = cw[0], w1 = cw[1024], w2 = cw[2048], w3 = cw[3072], cb = a.in[I_CONVB][l * 1024 + 64 * n + c];
    u32x4 xin[3];
#define LRU_FETCH(p_) do { const int b_ = (p_) >> 6, tb_ = ((p_) & 63) * 128; _Pragma("unroll") for (int q_ = 0; q_ < 3; ++q_) { const int idx_ = tid + 512 * q_; const int row_ = idx_ >> 3, c8_ = idx_ & 7, tt_ = tb_ - 3 + row_; \
        xin[q_] = (u32x4){0u, 0u, 0u, 0u}; if (idx_ < 1048 && tt_ >= 0) xin[q_] = *(const u32x4*)(cols + ((size_t)b_ * S + tt_) * NIN + C_LRUX + 64 * n + 8 * c8_); } } while (0)
    LRU_FETCH(p0);
    u32x2 pcur[7]; LAS u32x2* pl = (LAS u32x2*)(lds + 104960 + wave * 6656) + lane;
    if (prep_m0 >= 0) { const bool hp = (prep_m0 & (S - 1)) != 0;
#pragma unroll
        for (int k = 0; k < 13; ++k) pl[64 * k] = hp ? *(const u32x2*)(cols + (size_t)(prep_m0 - 1) * NIN + C_RW + 4 * lane + 256 * k) : (u32x2){0u, 0u}; }
#pragma nounroll
    for (int i = 0; i < 16; ++i) {
        const int p = p0 + 16 * i, b = p >> 6, ck = p & 63, tb = ck * 128; const size_t rb = (size_t)b * S;
        if (prep_m0 >= 0) rw_prep_load<0, 7>(cols, prep_m0 + i, lane, pcur);
        float* sm = summ + ((size_t)((b * 16 + n) * 64) * 64) * 2;
#pragma unroll
        for (int q = 0; q < 3; ++q) { const int idx = tid + 512 * q; if (idx < 1048) *(LAS u32x4*)(XS + (idx >> 3) * 64 + 8 * (idx & 7)) = xin[q]; }
        __syncthreads();
        if (i + 1 < 16) LRU_FETCH(p + 16);
#pragma unroll 4
        for (int q = 0; q < 16; ++q) { const int tr = (tid >> 6) + 8 * q;
            const float xc = cb + w0 * bf2f(XS[(tr + 3) * 64 + c]) + w1 * bf2f(XS[(tr + 2) * 64 + c]) + w2 * bf2f(XS[(tr + 1) * 64 + c]) + w3 * bf2f(XS[tr * 64 + c]);
            XA[tr * 72 + c] = f2bf(xc); }
        __syncthreads();
        if (prep_m0 >= 0) rw_prep_row<0, 7>(a, l, prep_m0 + i, lane, pl, pcur);
        { const bf16x8 a0 = *(const LAS bf16x8*)(XA + (16 * wave + fr) * 72 + 8 * fq), a1 = *(const LAS bf16x8*)(XA + (16 * wave + fr) * 72 + 32 + 8 * fq);
#pragma unroll
          for (int ct = 0; ct < 4; ++ct) {
              f32x4 accR = (f32x4){0.f, 0.f, 0.f, 0.f}, accI = accR;
              accR = MFMA16(a0, wa[ct][0], accR); accR = MFMA16(a1, wa[ct][1], accR);
              accI = MFMA16(a0, wx[ct][0], accI); accI = MFMA16(a1, wx[ct][1], accI);
              const int cc = 16 * ct + fr;
#pragma unroll
              for (int r = 0; r < 4; ++r) { const int tr = 16 * wave + 4 * fq + r;
                  const float rr = sigm(accR[r] + ba[ct]), ii = sigm(accI[r] + bx[ct]), la = -8.0f * rr * spl[ct], av = __expf(la);
                  const float xc = bf2f(XA[tr * 72 + cc]);
                  AA[tr * 64 + cc] = av; BBv[tr * 64 + cc] = sqrtf(fmaxf(1.0f - __expf(2.0f * la), 0.f)) * ii * xc; } } }
        __syncthreads();
        if (prep_m0 >= 0) rw_prep_load<7, 13>(cols, prep_m0 + i, lane, pcur);
        { float Ap = 1.f, Hh = 0.f;
#pragma unroll 4
          for (int j = 0; j < 16; ++j) { const float av = AA[(16 * seg + j) * 64 + c], bv = BBv[(16 * seg + j) * 64 + c]; Hh = av * Hh + bv; Ap *= av; }
          SEG[(seg * 64 + c) * 2] = Ap; SEG[(seg * 64 + c) * 2 + 1] = Hh; }
        __syncthreads();
        {
            float Pp = 1.f, h = 0.f;
            for (int s = 0; s < seg; ++s) { const float sa = SEG[(s * 64 + c) * 2], sh = SEG[(s * 64 + c) * 2 + 1]; h = sa * h + sh; Pp *= sa; }
            const int ch = 64 * n + c;
#pragma unroll 4
            for (int j = 0; j < 16; ++j) { const int tr = 16 * seg + j; const float av = AA[tr * 64 + c]; h = av * h + BBv[tr * 64 + c]; Pp *= av;
                HL[(rb + tb + tr) * 1024 + ch] = f2bf(h); PT[(rb + tb + tr) * 1024 + ch] = f2bf(Pp); }
            if (seg == 7) { sm[((size_t)ck * 64 + c) * 2] = Pp; sm[((size_t)ck * 64 + c) * 2 + 1] = h; }
        }
        if (prep_m0 >= 0) rw_prep_row<7, 13>(a, l, prep_m0 + i, lane, pl, pcur);
        __syncthreads();
    }
#undef LRU_FETCH
}
DI void lru_carry(const PA& a, int tid) {
    unsigned char* ws = a.ws; const float* summ = (const float*)(ws + WS_SUMM); float* car = (float*)(ws + WS_CARRY);
    const int gid = blockIdx.x * 512 + tid; if (gid >= 4096) return;
    const int bn = gid >> 6, c = gid & 63; const float* sm = summ + ((size_t)bn * 64 * 64) * 2; float h = 0.f;
#pragma nounroll
    for (int q0 = 0; q0 < 64; q0 += 16) {
        float2 v[16];
#pragma unroll
        for (int j = 0; j < 16; ++j) v[j] = *(const float2*)(sm + ((size_t)(q0 + j) * 64 + c) * 2);
#pragma unroll
        for (int j = 0; j < 16; ++j) { car[((size_t)bn * 64 + q0 + j) * 64 + c] = h; h = v[j].x * h + v[j].y; } }
}
DI void lru_finish_row(const PA& a, int m, int lane) {
    unsigned char* ws = a.ws; const bf16* cols = (const bf16*)(ws + WS_COLS); bf16* YA = (bf16*)(ws + WS_YA); const bf16* PT = (const bf16*)(ws + WS_H); const float* car = (const float*)(ws + WS_CARRY);
    const int b = m >> 13, ck = (m & (S - 1)) >> 7;
#pragma unroll
    for (int j = 0; j < 4; ++j) { const int ch = 256 * j + 4 * lane; const size_t off = (size_t)m * 1024 + ch;
        const f32x4 hl = load4bf(YA + off), pt = load4bf(PT + off), gt = load4bf(cols + (size_t)m * NIN + C_LRUG + ch);
        const f32x4 cr = *(const f32x4*)(car + ((size_t)((b * 16 + (ch >> 6)) * 64 + ck)) * 64 + (ch & 63));
        const f32x4 h = hl + pt * cr;
        store4bf(YA + off, (f32x4){gelu_tanh(gt.x) * h.x, gelu_tanh(gt.y) * h.y, gelu_tanh(gt.z) * h.z, gelu_tanh(gt.w) * h.w}); }
}

struct LruFin { u32x2 hl[2], pt[2], gt[2]; f32x4 cr[2]; };
DI void lru_fin_load(const PA& a, int m, int jh, int lane, LruFin& r) {
    unsigned char* ws = a.ws; const bf16* cols = (const bf16*)(ws + WS_COLS); const bf16* YA = (const bf16*)(ws + WS_YA); const bf16* PT = (const bf16*)(ws + WS_H); const float* car = (const float*)(ws + WS_CARRY);
    const int b = m >> 13, ck = (m & (S - 1)) >> 7;
#pragma unroll
    for (int q = 0; q < 2; ++q) { const int ch = 256 * (2 * jh + q) + 4 * lane; const size_t off = (size_t)m * 1024 + ch;
        r.hl[q] = *(const u32x2*)(YA + off); r.pt[q] = *(const u32x2*)(PT + off); r.gt[q] = *(const u32x2*)(cols + (size_t)m * NIN + C_LRUG + ch);
        r.cr[q] = *(const f32x4*)(car + ((size_t)((b * 16 + (ch >> 6)) * 64 + ck)) * 64 + (ch & 63)); }
}
DI void lru_fin_store(const PA& a, int m, int jh, int lane, const LruFin& r) {
    bf16* YA = (bf16*)(a.ws + WS_YA);
#pragma unroll
    for (int q = 0; q < 2; ++q) { const int ch = 256 * (2 * jh + q) + 4 * lane; const size_t off = (size_t)m * 1024 + ch;
        const f32x4 hl = (f32x4){bflo(r.hl[q].x), bfhi(r.hl[q].x), bflo(r.hl[q].y), bfhi(r.hl[q].y)}, pt = (f32x4){bflo(r.pt[q].x), bfhi(r.pt[q].x), bflo(r.pt[q].y), bfhi(r.pt[q].y)};
        const f32x4 gt = (f32x4){bflo(r.gt[q].x), bfhi(r.gt[q].x), bflo(r.gt[q].y), bfhi(r.gt[q].y)};
        const f32x4 h = hl + pt * r.cr[q];
        store4bf(YA + off, (f32x4){gelu_tanh(gt.x) * h.x, gelu_tanh(gt.y) * h.y, gelu_tanh(gt.z) * h.z, gelu_tanh(gt.w) * h.w}); }
}

DI void vt_item(const bf16* cols, bf16* Vt, int item, LAS bf16* scr, int lane) {
    const int st = item & 255, hd = (item >> 8) & 7, b = item >> 11; const int s0 = st * 32;
#pragma unroll
    for (int i = 0; i < 8; ++i) { const int idx = i * 64 + lane, row = idx >> 4, c8 = idx & 15;
        const u32x4 v = *(const u32x4*)(cols + ((size_t)b * S + s0 + row) * NIN + C_V + hd * 128 + 8 * c8);
        LAS unsigned* d = (LAS unsigned*)(scr + row * 130 + 8 * c8); d[0] = v.x; d[1] = v.y; d[2] = v.z; d[3] = v.w; }
    LDS_WAIT();
#pragma unroll
    for (int i = 0; i < 8; ++i) { const int idx = i * 64 + lane, d = idx >> 2, q = idx & 3;
        unsigned w[4];
#pragma unroll
        for (int p = 0; p < 4; ++p) { const unsigned lo = scr[(8 * q + 2 * p) * 130 + d], hi = scr[(8 * q + 2 * p + 1) * 130 + d]; w[p] = lo | (hi << 16); }
        *(u32x4*)(Vt + (((size_t)(b * 8 + hd) * 256 + st) * 128 + d) * 32 + 8 * q) = (u32x4){w[0], w[1], w[2], w[3]}; }
    LDS_WAIT();
}

DI void rw_prep_wave(const PA& a, int l, int m0, int lane) {
    unsigned char* ws = a.ws; const bf16* cols = (const bf16*)(ws + WS_COLS);
    bf16* KK = (bf16*)(ws + WS_KK); bf16* KP = (bf16*)(ws + WS_KP); bf16* R = (bf16*)(ws + WS_R); bf16* V = (bf16*)(ws + WS_V); bf16* AP = (bf16*)(ws + WS_AP);
    const float* mu = a.in[I_MU] + l * 3328; const float* kkw = a.in[I_KK] + l * 1024;
    u32x2 prv[13], cur[13], nxt[13];
    const bf16* base = cols + (size_t)m0 * NIN + C_RW + 4 * lane;
    const bool has_prev0 = (m0 & (S - 1)) != 0;
#pragma unroll
    for (int k = 0; k < 13; ++k) { cur[k] = *(const u32x2*)(base + 256 * k); prv[k] = has_prev0 ? *(const u32x2*)(base - NIN + 256 * k) : (u32x2){0u, 0u}; }
#pragma nounroll
    for (int i = 0; i < 16; ++i) {
        const int m = m0 + i;
        if (i + 1 < 16) {
#pragma unroll
            for (int k = 0; k < 13; ++k) nxt[k] = *(const u32x2*)(base + (size_t)(i + 1) * NIN + 256 * k); }
#pragma unroll
        for (int k = 0; k < 12; ++k) { const int sec = k >> 2, col = 256 * (k & 3) + 4 * lane, cc = 1024 * sec + col;
            const f32x4 xc = (f32x4){bflo(cur[k].x), bfhi(cur[k].x), bflo(cur[k].y), bfhi(cur[k].y)}, xp = (f32x4){bflo(prv[k].x), bfhi(prv[k].x), bflo(prv[k].y), bfhi(prv[k].y)};
            const f32x4 xs = xc + *(const f32x4*)(mu + cc) * (xp - xc);
            if (sec == 0) store4bf(R + (size_t)m * 1024 + col, xs);
            else if (sec == 2) store4bf(V + (size_t)m * 1024 + col, xs);
            else { store4bf(KP + (size_t)m * 1024 + col, xs);
                const f32x4 kv = xs * *(const f32x4*)(kkw + col);
                const float ssq = grp16_sum((kv.x * kv.x + kv.y * kv.y) + (kv.z * kv.z + kv.w * kv.w), lane);
                const float inv = 1.0f / fmaxf(sqrtf(ssq), 1e-12f);
                store4bf(KK + (size_t)m * 1024 + col, kv * inv); } }
        { const int cc = 3072 + 4 * lane;
          const f32x4 xc = (f32x4){bflo(cur[12].x), bfhi(cur[12].x), bflo(cur[12].y), bfhi(cur[12].y)}, xp = (f32x4){bflo(prv[12].x), bfhi(prv[12].x), bflo(prv[12].y), bfhi(prv[12].y)};
          const f32x4 xs = xc + *(const f32x4*)(mu + cc) * (xp - xc); f32x4 o;
          if (lane < 16) { o.x = 1.0f - 2.0f * frcp(__expf(2.0f * xs.x) + 1.0f); o.y = 1.0f - 2.0f * frcp(__expf(2.0f * xs.y) + 1.0f); o.z = 1.0f - 2.0f * frcp(__expf(2.0f * xs.z) + 1.0f); o.w = 1.0f - 2.0f * frcp(__expf(2.0f * xs.w) + 1.0f); }
          else if (lane < 32) o = xs;
          else { o.x = sigm(xs.x); o.y = sigm(xs.y); o.z = sigm(xs.z); o.w = sigm(xs.w); }
          store4bf(AP + (size_t)m * 256 + 4 * lane, o); }
#pragma unroll
        for (int k = 0; k < 13; ++k) { prv[k] = cur[k]; cur[k] = nxt[k]; }
    }
}

#ifndef ATT_THR
#define ATT_THR 150.0f
#endif
constexpr int ATT_KP = 272, ATT_VP = 72, ATT_LDS = 32 * ATT_KP + 128 * ATT_VP;
DI void attn_strip(const bf16* cols, const bf16* Vt, bf16* YB, int item, int lane, LAS unsigned char* wl) {
    const int strip = item & 255, hd = (item >> 8) & 7, b = item >> 11;
    const int r = lane & 31, h = lane >> 5, t0 = strip * 32; const size_t rb = (size_t)b * S;
    LAS unsigned char* kb = wl; LAS unsigned char* vb = wl + 32 * ATT_KP;
    bf16x8 qf[8];
    {
        const bf16* qg = cols + (rb + t0 + (lane >> 4)) * NIN + C_Q + hd * 128 + 8 * (lane & 15);
        u32x4 tq[8];
#pragma unroll
        for (int i = 0; i < 8; ++i) tq[i] = *(const u32x4*)(qg + (size_t)(4 * i) * NIN);
#pragma unroll
        for (int i = 0; i < 8; ++i) *(LAS u32x4*)(kb + (4 * i + (lane >> 4)) * ATT_KP + 16 * (lane & 15)) = tq[i];
        LDS_WAIT();
#pragma unroll
        for (int kk = 0; kk < 8; ++kk) qf[kk] = *(const LAS bf16x8*)(kb + r * ATT_KP + 32 * kk + 16 * h);
        LDS_WAIT(); }
    f32x16 o[4];
#pragma unroll
    for (int dt = 0; dt < 4; ++dt)
#pragma unroll
        for (int i = 0; i < 16; ++i) o[dt][i] = 0.f;
    float R = 0.f;
    const float scl = 0.08838834764831845f * 1.4426950408889634f;
    const bf16* kg = cols + (rb + (lane >> 4)) * NIN + C_K + hd * 128 + 8 * (lane & 15);
    const bf16* vg = Vt + ((size_t)(b * 8 + hd) * 256 * 128 + (lane >> 2)) * 32 + 8 * (lane & 3);
    u32x4 tk[8], tv[8];
#define ATT_FETCH(s0_) do { _Pragma("unroll") for (int i_ = 0; i_ < 8; ++i_) { tk[i_] = *(const u32x4*)(kg + (size_t)((s0_) + 4 * i_) * NIN); tv[i_] = *(const u32x4*)(vg + (size_t)((s0_) >> 5) * 4096 + 512 * i_); } } while (0)
#define ATT_STASH() do { _Pragma("unroll") for (int i_ = 0; i_ < 8; ++i_) { *(LAS u32x4*)(kb + (4 * i_ + (lane >> 4)) * ATT_KP + 16 * (lane & 15)) = tk[i_]; \
            LAS unsigned char* vd_ = vb + (16 * i_ + (lane >> 2)) * ATT_VP + 16 * (lane & 3); *(LAS u32x2*)vd_ = (u32x2){tv[i_].x, tv[i_].y}; *(LAS u32x2*)(vd_ + 8) = (u32x2){tv[i_].z, tv[i_].w}; } } while (0)
    ATT_FETCH(t0); ATT_STASH();
    for (int s0 = t0; s0 >= 0; s0 -= 32) {
        if (s0 >= 32) ATT_FETCH(s0 - 32);
        f32x16 st;
#pragma unroll
        for (int i = 0; i < 16; ++i) st[i] = 0.f;
#pragma unroll
        for (int kk = 0; kk < 8; ++kk) st = MFMA32(*(const LAS bf16x8*)(kb + r * ATT_KP + 32 * kk + 16 * h), qf[kk], st);
        const bool diag = (s0 == t0);
        float zz[16], e[16];
#pragma unroll
        for (int i = 0; i < 16; ++i) { const float z = st[i] * scl; zz[i] = z; const bool valid = !diag || (crow(i, h) < r);
            const float sp = fmaxf(z, 0.f) + flog2(1.0f + fexp2(-fabsf(z)));
            e[i] = valid ? sp : 0.f; }
        float T[4], Tp[4];
#pragma unroll
        for (int g = 0; g < 4; ++g) { e[4 * g + 2] += e[4 * g + 3]; e[4 * g + 1] += e[4 * g + 2]; e[4 * g] += e[4 * g + 1]; T[g] = e[4 * g]; Tp[g] = SHX(T[g], 32); }
        const float G0 = T[0] + Tp[0], G1 = T[1] + Tp[1], G2 = T[2] + Tp[2], G3 = T[3] + Tp[3];
        float off[4]; off[3] = R; off[2] = R + G3; off[1] = off[2] + G2; off[0] = off[1] + G1;
        const float total = (off[0] - R) + G0;
#pragma unroll
        for (int g = 0; g < 4; ++g) if (h == 0) off[g] += Tp[g];
        float p[16];
#pragma unroll
        for (int i = 0; i < 16; ++i) { const bool valid = !diag || (crow(i, h) < r); const float w = fexp2(zz[i] - (e[i] + off[i >> 2])); p[i] = valid ? w : 0.f; }
        R += total;
        bf16x8 pa[2];
#pragma unroll
        for (int s = 0; s < 2; ++s) { u32x4 w; w.x = cvtpk(p[8 * s], p[8 * s + 1]); w.y = cvtpk(p[8 * s + 2], p[8 * s + 3]); w.z = cvtpk(p[8 * s + 4], p[8 * s + 5]); w.w = cvtpk(p[8 * s + 6], p[8 * s + 7]); pa[s] = __builtin_bit_cast(bf16x8, w); }
#pragma unroll
        for (int dt = 0; dt < 4; ++dt)
#pragma unroll
            for (int s = 0; s < 2; ++s) { const LAS unsigned char* vp = vb + (32 * dt + r) * ATT_VP + 32 * s + 8 * h;
                const u32x2 lo = *(const LAS u32x2*)vp, hi = *(const LAS u32x2*)(vp + 16);
                o[dt] = MFMA32(__builtin_bit_cast(bf16x8, (u32x4){lo.x, lo.y, hi.x, hi.y}), pa[s], o[dt]); }
        if (__all(R >= ATT_THR)) break;
        if (s0 >= 32) ATT_STASH();
    }
#undef ATT_FETCH
#undef ATT_STASH
#pragma unroll
    for (int dt = 0; dt < 4; ++dt)
#pragma unroll
        for (int g = 0; g < 4; ++g) { u32x2 w; w.x = cvtpk(o[dt][4 * g], o[dt][4 * g + 1]); w.y = cvtpk(o[dt][4 * g + 2], o[dt][4 * g + 3]); *(LAS u32x2*)(kb + r * ATT_KP + 2 * (32 * dt + 8 * g + 4 * h)) = w; }
    LDS_WAIT();
    { bf16* yg = YB + (rb + t0 + (lane >> 4)) * 1024 + hd * 128 + 8 * (lane & 15);
#pragma unroll
      for (int i = 0; i < 8; ++i) *(u32x4*)(yg + (size_t)(4 * i) * 1024) = *(const LAS u32x4*)(kb + (4 * i + (lane >> 4)) * ATT_KP + 16 * (lane & 15)); }
    LDS_WAIT();
}

constexpr int RWP = 72;
#define RWB(k) ((LAS bf16*)(lds + (k) * 9216))
DI f32x16 rw_tile(const LAS bf16* A, const LAS bf16* Bt, int tm, int tn, int r, int h, f32x16 acc) {
    const LAS bf16* ap = A + (32 * tm + r) * RWP + 8 * h; const LAS bf16* bp = Bt + (32 * tn + r) * RWP + 8 * h;
#pragma unroll
    for (int ks = 0; ks < 4; ++ks) acc = MFMA32(*(const LAS bf16x8*)(ap + 16 * ks), *(const LAS bf16x8*)(bp + 16 * ks), acc);
    return acc;
}
DI void rw_store_rm(LAS bf16* D, int tm, int tn, int r, int h, const f32x16& x) {
#pragma unroll
    for (int i = 0; i < 16; ++i) D[(32 * tm + crow(i, h)) * RWP + 32 * tn + r] = f2bf(x[i]);
}
DI void rw_store_tr(LAS bf16* D, int tm, int tn, int r, int h, const f32x16& x) {
#pragma unroll
    for (int g = 0; g < 4; ++g) { u32x2 w; w.x = cvtpk(x[4 * g], x[4 * g + 1]); w.y = cvtpk(x[4 * g + 2], x[4 * g + 3]); *(LAS u32x2*)(D + (32 * tn + r) * RWP + 32 * tm + 8 * g + 4 * h) = w; }
}
DI f32x16 f16zero() { f32x16 z;
#pragma unroll
    for (int i = 0; i < 16; ++i) z[i] = 0.f;
    return z; }

DI void rw1_load(const PA& a, int bh, int ck, int lane, int wave, u32x4 (&d)[6]) {
    unsigned char* ws = a.ws; const int b = bh >> 4, hd = bh & 15; const int tid_ = wave * 64 + lane;
    const size_t go = ((size_t)b * S + (size_t)ck * 64 + (tid_ >> 3)) * 1024 + hd * 64 + 8 * (tid_ & 7);
    d[0] = *(const u32x4*)((const bf16*)(ws + WS_KK) + go); d[1] = *(const u32x4*)((const bf16*)(ws + WS_BB) + go); d[2] = *(const u32x4*)((const bf16*)(ws + WS_KP) + go);
    d[3] = *(const u32x4*)((const bf16*)(ws + WS_R) + go); d[4] = *(const u32x4*)((const bf16*)(ws + WS_V) + go); d[5] = *(const u32x4*)((const bf16*)(ws + WS_OM) + go);
}
DI void rw1_unit(const PA& a, int l, int bh, int ck, LAS unsigned char* lds, int tid, int lane, int wave, const u32x4 (&in)[6], bool has_next, int nbh, int nck, u32x4 (&nx)[6], int cvt_it, int lru_m = -1, int lru_jh = 0, bool dummy = false) {
    LruFin lfr; if (lru_m >= 0) lru_fin_load(a, lru_m, lru_jh, lane, lfr);
    f32x4 cvr[8]; if (cvt_it >= 0) cvt_item_load(a, l, cvt_it, lane, cvr);
    unsigned char* ws = a.ws;
    bf16* KK = (bf16*)(ws + WS_KK); bf16* BBg = (bf16*)(ws + WS_BB); bf16* KP = (bf16*)(ws + WS_KP); bf16* Rg = (bf16*)(ws + WS_R); bf16* EW = (bf16*)(ws + WS_OM); const bf16* Vg = (const bf16*)(ws + WS_V);
    LAS float* RKP = (LAS float*)(lds + 16 * 9216);
    LAS float* GC = (LAS float*)(lds + 16 * 9216 + 2048);
    const int b = bh >> 4, hd = bh & 15, col0 = hd * 64; const size_t tok0 = (size_t)b * S + (size_t)ck * 64;
    const int r = lane & 31, h = lane >> 5;
    float bv[8];
    {
        const int t = lane, j0 = 8 * wave; const size_t go = (tok0 + t) * 1024 + col0 + j0;
        float kkf[8], bbf[8], kpf[8], rf[8], vf[8], ewf[8];
#pragma unroll
        for (int q = 0; q < 6; ++q) *(LAS u32x4*)(RWB(8 + q) + (tid >> 3) * RWP + 8 * (tid & 7)) = in[q];
        __syncthreads();
        pg8::unpack8(*(const LAS u32x4*)(RWB(8) + t * RWP + j0), kkf); pg8::unpack8(*(const LAS u32x4*)(RWB(9) + t * RWP + j0), bbf); pg8::unpack8(*(const LAS u32x4*)(RWB(10) + t * RWP + j0), kpf);
        pg8::unpack8(*(const LAS u32x4*)(RWB(11) + t * RWP + j0), rf); pg8::unpack8(*(const LAS u32x4*)(RWB(12) + t * RWP + j0), vf); pg8::unpack8(*(const LAS u32x4*)(RWB(13) + t * RWP + j0), ewf); (void)go;
        const float* rkw = a.in[I_RK] + l * 1024 + col0 + j0;
        float cl[8], pr = 0.f;
#pragma unroll
        for (int q = 0; q < 8; ++q) { cl[q] = -ewf[q]; pr += rf[q] * kpf[q] * rkw[q]; }
#pragma unroll
        for (int d = 1; d < 64; d <<= 1) {
#pragma unroll
            for (int q = 0; q < 8; ++q) { const float up = SHUP(cl[q], d); cl[q] += (lane >= d) ? up : 0.f; } }
        float At[8], Bt[8], Kt[8], Rt[8], Bp[8], Kp[8];
#pragma unroll
        for (int q = 0; q < 8; ++q) { const float clC = SHLANE(cl[q], 63);
            const float e1 = __expf(cl[q] + ewf[q]), e2 = __expf(-cl[q]), e3 = __expf(cl[q]), e4 = __expf(clC - cl[q]);
            At[q] = -kkf[q] * e1; Bt[q] = bbf[q] * e2; Kt[q] = kpf[q] * e2; Rt[q] = rf[q] * e3; Bp[q] = bbf[q] * e4; Kp[q] = kpf[q] * e4;
            if (lane == 63) GC[j0 + q] = e3; }
        *(LAS u32x4*)(RWB(0) + t * RWP + j0) = pg8::pack8(At); *(LAS u32x4*)(RWB(1) + t * RWP + j0) = pg8::pack8(Bt);
        *(LAS u32x4*)(RWB(2) + t * RWP + j0) = pg8::pack8(Kt); *(LAS u32x4*)(RWB(3) + t * RWP + j0) = pg8::pack8(Rt);
#pragma unroll
        for (int q = 0; q < 8; ++q) { RWB(4)[(j0 + q) * RWP + t] = f2bf(At[q]); RWB(5)[(j0 + q) * RWP + t] = f2bf(Bp[q]); RWB(6)[(j0 + q) * RWP + t] = f2bf(Kp[q]); RWB(7)[(j0 + q) * RWP + t] = f2bf(vf[q]); bv[q] = vf[q]; }
        RKP[wave * 64 + t] = pr;
    }
    __syncthreads();
    if (has_next) rw1_load(a, nbh, nck, lane, wave, nx);
    {
        const int t = lane; float rk = 0.f;
#pragma unroll
        for (int w = 0; w < 8; ++w) rk += RKP[w * 64 + t];
#pragma unroll
        for (int q = 0; q < 8; ++q) bv[q] *= rk;
        *(LAS u32x4*)(RWB(15) + t * RWP + 8 * wave) = pg8::pack8(bv);
    }
    {
        const int mat = wave >> 1, tm = wave & 1;
        const LAS bf16* Aop = (mat < 2) ? RWB(0) : RWB(3); const LAS bf16* Bop = (mat & 1) ? RWB(2) : RWB(1);
#pragma unroll
        for (int tn = 0; tn < 2; ++tn) {
            f32x16 x = rw_tile(Aop, Bop, tm, tn, r, h, f16zero());
#pragma unroll
            for (int i = 0; i < 16; ++i) { const int m = 32 * tm + crow(i, h), n = 32 * tn + r; const bool keep = (mat < 2) ? (m > n) : (m >= n); x[i] = keep ? x[i] : 0.f; }
            if (mat == 0) { rw_store_rm(RWB(11), tm, tn, r, h, x); rw_store_tr(RWB(12), tm, tn, r, h, x);
#pragma unroll
                for (int i = 0; i < 16; ++i) if (32 * tm + crow(i, h) == 32 * tn + r) x[i] += 1.0f;
                rw_store_rm(RWB(13), tm, tn, r, h, x); }
            else rw_store_rm(mat == 1 ? RWB(8) : mat == 2 ? RWB(9) : RWB(10), tm, tn, r, h, x);
        }
    }
    __syncthreads();
    *(u32x4*)((dummy ? (bf16*)(ws + WS_AP) : KK) + (tok0 + (tid >> 3)) * 1024 + col0 + 8 * (tid & 7)) = *(const LAS u32x4*)(RWB(15) + (tid >> 3) * RWP + 8 * (tid & 7));
    const int qt = wave & 3, tm4 = qt >> 1, tn4 = qt & 1;
    f32x16 Treg = f16zero();
    if (wave < 4) { f32x16 x = rw_tile(RWB(11), RWB(12), tm4, tn4, r, h, f16zero()); rw_store_rm(RWB(0), tm4, tn4, r, h, x); rw_store_tr(RWB(1), tm4, tn4, r, h, x); }
    else { f32x16 x = rw_tile(RWB(8), RWB(7), tm4, tn4, r, h, f16zero()); rw_store_tr(RWB(14), tm4, tn4, r, h, x);
#pragma unroll
        for (int i = 0; i < 16; ++i) Treg[i] = bf2f(RWB(13)[(32 * tm4 + crow(i, h)) * RWP + 32 * tn4 + r]); }
    __syncthreads();
    if (lru_m >= 0) lru_fin_store(a, lru_m, lru_jh, lane, lfr);
#pragma unroll
    for (int st = 0; st < 5; ++st) {
        const bool odd = (st & 1) != 0;
        const LAS bf16* Lr = odd ? RWB(11) : RWB(0); const LAS bf16* Lt = odd ? RWB(12) : RWB(1);
        if (wave < 4) { if (st < 4) { f32x16 x = rw_tile(Lr, Lt, tm4, tn4, r, h, f16zero()); rw_store_rm(odd ? RWB(0) : RWB(11), tm4, tn4, r, h, x); rw_store_tr(odd ? RWB(1) : RWB(12), tm4, tn4, r, h, x); } }
        else { Treg = rw_tile(odd ? RWB(2) : RWB(13), Lt, tm4, tn4, r, h, Treg); rw_store_rm(odd ? RWB(13) : RWB(2), tm4, tn4, r, h, Treg); }
        __syncthreads();
    }
    if (wave < 4) { f32x16 x = rw_tile(RWB(2), RWB(4), tm4, tn4, r, h, f16zero()); rw_store_tr(RWB(15), tm4, tn4, r, h, x); }
    else { f32x16 x = rw_tile(RWB(2), RWB(14), tm4, tn4, r, h, f16zero()); rw_store_tr(RWB(8), tm4, tn4, r, h, x); }
    __syncthreads();
    {
        const int mat = wave >> 1, tm = wave & 1;
        bf16* dst = dummy ? (bf16*)(ws + WS_AP) : (mat == 0) ? Rg : (mat == 1) ? BBg : (mat == 2) ? EW : KP;
#pragma unroll
        for (int tn = 0; tn < 2; ++tn) {
            f32x16 x = f16zero();
            if (mat == 0) x = rw_tile(RWB(15), RWB(9), tm, tn, r, h, x);
            else if (mat == 1) { x = rw_tile(RWB(8), RWB(9), tm, tn, r, h, x); x = rw_tile(RWB(7), RWB(10), tm, tn, r, h, x); }
            else if (mat == 2) x = rw_tile(RWB(15), RWB(5), tm, tn, r, h, x);
            else { x = rw_tile(RWB(5), RWB(8), tm, tn, r, h, x); x = rw_tile(RWB(6), RWB(7), tm, tn, r, h, x); }
            const int n = 32 * tn + r;
#pragma unroll
            for (int g = 0; g < 4; ++g) { const int m = 32 * tm + 8 * g + 4 * h;
                f32x4 o = (f32x4){x[4 * g], x[4 * g + 1], x[4 * g + 2], x[4 * g + 3]};
                if (mat == 0) { const u32x2 w = *(const LAS u32x2*)(RWB(3) + n * RWP + m); o += (f32x4){bflo(w.x), bfhi(w.x), bflo(w.y), bfhi(w.y)}; }
                if (mat == 2) { const float gc = GC[n];
#pragma unroll
                    for (int e = 0; e < 4; ++e) if (m + e == n) o[e] += gc; }
                { u32x2 ow; ow.x = cvtpk(o.x, o.y); ow.y = cvtpk(o.z, o.w); *(LAS u32x2*)(RWB(11 + mat) + n * RWP + m) = ow; }
                }
        }
        (void)dst;
    }
    __syncthreads();
#pragma unroll
    for (int q = 0; q < 4; ++q) { bf16* dq = dummy ? (bf16*)(ws + WS_AP) : (q == 0) ? Rg : (q == 1) ? BBg : (q == 2) ? EW : KP;
        *(u32x4*)(dq + (tok0 + (tid >> 3)) * 1024 + col0 + 8 * (tid & 7)) = *(const LAS u32x4*)(RWB(11 + q) + (tid >> 3) * RWP + 8 * (tid & 7)); }
    if (cvt_it >= 0) cvt_item_finish(a, l, cvt_it, lane, cvr, (LAS float*)(lds + wave * 9216));
    __syncthreads();
}

constexpr int RW2_SLOT = 10240, RW2_NSLOT = 5, RW2_RING_OFF = 4096, RW2_RING_END = RW2_RING_OFF + RW2_NSLOT * RW2_SLOT;
DI void rw2_chain(const PA& a, int bh, int ib, LAS unsigned char* lds, int lane) {
    unsigned char* ws = a.ws; const bf16* EW = (const bf16*)(ws + WS_OM); const bf16* KP = (const bf16*)(ws + WS_KP); bf16* Vg = (bf16*)(ws + WS_V);
    LAS bf16* Sl = (LAS bf16*)lds;
    LAS unsigned char* ring = lds + RW2_RING_OFF;
    const int b = bh >> 4, hd = bh & 15, col0 = hd * 64, fr = lane & 15, fq = lane >> 4; const size_t tokb = (size_t)b * S;
    for (int idx = lane; idx < 16 * RWP / 2; idx += 64) ((LAS unsigned*)Sl)[idx] = 0u;
    { bf16* z0 = Vg + (tokb + 16 * ib + fr) * 1024 + col0 + 16 * fq; const u32x4 zz = zero4(); *(u32x4*)z0 = zz; *(u32x4*)(z0 + 8) = zz; }
    const int prow = lane >> 3, pchk = lane & 7;
    const bf16* pg = EW + (tokb + prow) * 1024 + col0;
    const bf16* qg = KP + (tokb + 16 * ib + prow) * 1024 + col0 + 8 * pchk;
    const int psw = 8 * (pchk ^ prow);
#define RW2_DMA(ck_) do { const int c_ = (ck_) < S / 64 ? (ck_) : S / 64 - 1; const int sl_ = (ck_) % RW2_NSLOT; LAS unsigned char* sb_ = ring + sl_ * RW2_SLOT; \
        _Pragma("unroll") for (int i_ = 0; i_ < 8; ++i_) __builtin_amdgcn_global_load_lds((const unsigned*)(pg + (size_t)(64 * c_ + 8 * i_) * 1024 + psw), (LAS unsigned*)(sb_ + i_ * 1024), 16, 0, 0); \
        _Pragma("unroll") for (int i_ = 0; i_ < 2; ++i_) __builtin_amdgcn_global_load_lds((const unsigned*)(qg + (size_t)(64 * c_ + 8 * i_) * 1024), (LAS unsigned*)(sb_ + 8192 + i_ * 1024), 16, 0, 0); } while (0)
    RW2_DMA(0); RW2_DMA(1); RW2_DMA(2); RW2_DMA(3);
    asm volatile("s_waitcnt vmcnt(0) lgkmcnt(0)" ::: "memory");
#pragma nounroll
    for (int ck = 0; ck < S / 64; ++ck) {
        asm volatile("s_waitcnt vmcnt(42)" ::: "memory");
        const LAS unsigned char* sb = ring + (ck % RW2_NSLOT) * RW2_SLOT;
        const bf16x8 s0 = *(const LAS bf16x8*)(Sl + fr * RWP + 8 * fq), s1 = *(const LAS bf16x8*)(Sl + fr * RWP + 32 + 8 * fq);
        f32x4 z[4];
#pragma unroll
        for (int jt = 0; jt < 4; ++jt) { const int row = 16 * jt + fr;
            const u32x2 qv = *(const LAS u32x2*)(sb + 8192 + fr * 128 + 32 * jt + 8 * fq);
            f32x4 acc = (f32x4){bflo(qv.x), bfhi(qv.x), bflo(qv.y), bfhi(qv.y)};
            const bf16x8 p0 = *(const LAS bf16x8*)(sb + row * 128 + 16 * (fq ^ (row & 7))), p1 = *(const LAS bf16x8*)(sb + row * 128 + 16 * ((4 + fq) ^ (row & 7)));
            acc = MFMA16(p0, s0, acc); acc = MFMA16(p1, s1, acc); z[jt] = acc; }
        LDS_WAIT();
#pragma unroll
        for (int jt = 0; jt < 4; ++jt) { u32x2 w; w.x = cvtpk(z[jt][0], z[jt][1]); w.y = cvtpk(z[jt][2], z[jt][3]);
            *(LAS u32x2*)(Sl + fr * RWP + 16 * jt + 4 * fq) = w;
            const int cn = ck + 1 < S / 64 ? ck + 1 : 0;
            if (ck + 1 < S / 64) *(u32x2*)(Vg + (tokb + (size_t)cn * 64 + 16 * ib + fr) * 1024 + col0 + 16 * jt + 4 * fq) = w; }
        LDS_WAIT();
        RW2_DMA(ck + 4);
    }
    asm volatile("s_waitcnt vmcnt(0)" ::: "memory");
#undef RW2_DMA
}

DI void rw3_unit(const PA& a, int l, int item, int lane, LAS unsigned char* wl) {
    unsigned char* ws = a.ws; const bf16* Sg = (const bf16*)(ws + WS_V); const bf16* Rg = (const bf16*)(ws + WS_R); const bf16* YL = (const bf16*)(ws + WS_BB); const bf16* BV = (const bf16*)(ws + WS_KK);
    const bf16* Gb = (const bf16*)(ws + WS_G); bf16* YC = (bf16*)(ws + WS_YC);
    const int th = item & 1, ck = (item >> 1) & 127, bh = item >> 8, b = bh >> 4, hd = bh & 15, col0 = hd * 64, r = lane & 31, h = lane >> 5;
    const size_t tok0 = (size_t)b * S + (size_t)ck * 64; const size_t trow = tok0 + 32 * th + r;
    const int srow = lane >> 3, schk = lane & 7; const size_t sg = (tok0 + 32 * th + srow) * 1024 + col0 + 8 * schk;
    u32x4 tl[3][4];
#pragma unroll
    for (int i = 0; i < 4; ++i) { tl[0][i] = *(const u32x4*)(YL + sg + (size_t)(8 * i) * 1024); tl[1][i] = *(const u32x4*)(BV + sg + (size_t)(8 * i) * 1024); tl[2][i] = *(const u32x4*)(Gb + sg + (size_t)(8 * i) * 1024); }
    f32x16 y[2]; y[0] = f16zero(); y[1] = f16zero();
    { const bf16* rp = Rg + trow * 1024 + col0 + 8 * h;
#pragma unroll
      for (int ks = 0; ks < 4; ++ks) { const bf16x8 bfr = *(const bf16x8*)(rp + 16 * ks);
#pragma unroll
          for (int ti = 0; ti < 2; ++ti) y[ti] = MFMA32(*(const bf16x8*)(Sg + (tok0 + 32 * ti + r) * 1024 + col0 + 16 * ks + 8 * h), bfr, y[ti]); } }
#pragma unroll
    for (int q = 0; q < 3; ++q)
#pragma unroll
        for (int i = 0; i < 4; ++i) *(LAS u32x4*)(wl + q * 4608 + (8 * i + srow) * 144 + 16 * schk) = tl[q][i];
    LDS_WAIT();
    float sum = 0.f;
#pragma unroll
    for (int ti = 0; ti < 2; ++ti)
#pragma unroll
        for (int g = 0; g < 4; ++g) { const u32x2 w = *(const LAS u32x2*)(wl + r * 144 + 2 * (32 * ti + 8 * g + 4 * h));
            y[ti][4 * g] += bflo(w.x); y[ti][4 * g + 1] += bfhi(w.x); y[ti][4 * g + 2] += bflo(w.y); y[ti][4 * g + 3] += bfhi(w.y);
            sum += (y[ti][4 * g] + y[ti][4 * g + 1]) + (y[ti][4 * g + 2] + y[ti][4 * g + 3]); }
    sum += SHX(sum, 32);
    const float mean = sum * (1.0f / 64.0f); float sq = 0.f;
#pragma unroll
    for (int ti = 0; ti < 2; ++ti)
#pragma unroll
        for (int i = 0; i < 16; ++i) { const float d = y[ti][i] - mean; y[ti][i] = d; sq += d * d; }
    sq += SHX(sq, 32);
    const float rstd = 1.0f / sqrtf(sq * (1.0f / 64.0f) + 64e-5f);
    const float* lw = a.in[I_LNW] + l * 1024 + col0; const float* lb = a.in[I_LNB] + l * 1024 + col0;
#pragma unroll
    for (int ti = 0; ti < 2; ++ti)
#pragma unroll
        for (int g = 0; g < 4; ++g) { const int i0 = 32 * ti + 8 * g + 4 * h;
            const u32x2 wb = *(const LAS u32x2*)(wl + 4608 + r * 144 + 2 * i0), wg = *(const LAS u32x2*)(wl + 9216 + r * 144 + 2 * i0);
            const f32x4 bvv = (f32x4){bflo(wb.x), bfhi(wb.x), bflo(wb.y), bfhi(wb.y)}, gg = (f32x4){bflo(wg.x), bfhi(wg.x), bflo(wg.y), bfhi(wg.y)};
            const f32x4 w4 = *(const f32x4*)(lw + i0), b4 = *(const f32x4*)(lb + i0);
            const f32x4 d = (f32x4){y[ti][4 * g], y[ti][4 * g + 1], y[ti][4 * g + 2], y[ti][4 * g + 3]};
            const f32x4 o = (d * rstd * w4 + b4 + bvv) * gg;
            u32x2 ow; ow.x = cvtpk(o.x, o.y); ow.y = cvtpk(o.z, o.w); *(LAS u32x2*)(wl + 13824 + r * 144 + 2 * i0) = ow; }
    LDS_WAIT();
#pragma unroll
    for (int i = 0; i < 4; ++i) *(u32x4*)(YC + sg + (size_t)(8 * i) * 1024) = *(const LAS u32x4*)(wl + 13824 + (8 * i + srow) * 144 + 16 * schk);
    LDS_WAIT();
}

#define DPPI(x_, ctrl_, rm_, bc_) __builtin_amdgcn_update_dpp(0, (int)(x_), ctrl_, rm_, 0xf, bc_)
DI unsigned wave_max_u32_dpp(unsigned x) {
    unsigned y;
    y = (unsigned)DPPI(x, 0x111, 0xf, true); x = x > y ? x : y; y = (unsigned)DPPI(x, 0x112, 0xf, true); x = x > y ? x : y;
    y = (unsigned)DPPI(x, 0x114, 0xf, true); x = x > y ? x : y; y = (unsigned)DPPI(x, 0x118, 0xf, true); x = x > y ? x : y;
    y = (unsigned)DPPI(x, 0x142, 0xa, false); x = x > y ? x : y; y = (unsigned)DPPI(x, 0x143, 0xc, false); x = x > y ? x : y;
    return (unsigned)__builtin_amdgcn_readlane((int)x, 63);
}
DI float wave_sum_dpp(float v) {
#define DPPF(ctrl_, rm_, bc_) __builtin_bit_cast(float, __builtin_amdgcn_update_dpp(0, __builtin_bit_cast(int, v), ctrl_, rm_, 0xf, bc_))
    v += DPPF(0x111, 0xf, true); v += DPPF(0x112, 0xf, true); v += DPPF(0x114, 0xf, true); v += DPPF(0x118, 0xf, true); v += DPPF(0x142, 0xa, false); v += DPPF(0x143, 0xc, false);
#undef DPPF
    return __builtin_bit_cast(float, __builtin_amdgcn_readlane(__builtin_bit_cast(int, v), 63));
}
DI void router_raw(const bf16* x1, int m, int lane, u32x2 (&raw)[4]) {
#pragma unroll
    for (int j = 0; j < 4; ++j) raw[j] = *(const u32x2*)(x1 + (size_t)m * 1024 + 4 * lane + 256 * j);
}
DI void router_row(const LAS float* MOD, const u32x2 (&raw)[4], bf16* H, int m, int lane, f32x4 (&v)[4]) {
    float ss = 0.f;
#pragma unroll
    for (int j = 0; j < 4; ++j) { v[j] = (f32x4){bflo(raw[j].x), bfhi(raw[j].x), bflo(raw[j].y), bfhi(raw[j].y)}; ss += (v[j].x * v[j].x + v[j].y * v[j].y) + (v[j].z * v[j].z + v[j].w * v[j].w); }
    const float rstd = 1.0f / sqrtf(wave_sum_dpp(ss) * (1.0f / 1024.0f) + 1e-6f);
#pragma unroll
    for (int j = 0; j < 4; ++j) { const int col = 4 * lane + 256 * j;
        v[j] = v[j] * rstd * *(const LAS f32x4*)(MOD + col) + *(const LAS f32x4*)(MOD + 1024 + col);
        store4bf(H + (size_t)m * 1024 + col, v[j]); }
}
DI float router_reduce(float (&p)[16], float be, int lane) {
#pragma unroll
    for (int e = 0; e < 8; ++e) { const bool up = (lane & 16) != 0; const float send = up ? p[e] : p[e + 8], keep = up ? p[e + 8] : p[e]; p[e] = keep + SHX(send, 16); }
#pragma unroll
    for (int e = 0; e < 4; ++e) { const bool up = (lane & 8) != 0; const float send = up ? p[e] : p[e + 4], keep = up ? p[e + 4] : p[e]; p[e] = keep + SHX(send, 8); }
#pragma unroll
    for (int e = 0; e < 2; ++e) { const bool up = (lane & 4) != 0; const float send = up ? p[e] : p[e + 2], keep = up ? p[e + 2] : p[e]; p[e] = keep + SHX(send, 4); }
    { const bool up = (lane & 2) != 0; const float send = up ? p[0] : p[1], keep = up ? p[1] : p[0]; p[0] = keep + SHX(send, 2); }
    float lg = p[0] + SHX(p[0], 1) + be; lg = (lg == lg) ? fminf(fmaxf(lg, -1.0e30f), 1.0e30f) : 0.f;
    return lg;
}
DI unsigned router_key(float lg, int e_own) { const unsigned u = __builtin_bit_cast(unsigned, lg); const unsigned o = (u & 0x80000000u) ? ~u : (u | 0x80000000u); return (o & ~31u) | (unsigned)(31 - e_own); }
DI void router_emit(const float (&tv)[4], const int (&ti)[4], int m, int sb, int lane, float* topw, LAS unsigned* hist, LAS unsigned* sel) {
    const float e1 = __expf(tv[1] - tv[0]), e2 = __expf(tv[2] - tv[0]), e3 = __expf(tv[3] - tv[0]); const float inv = 1.0f / (1.0f + e1 + e2 + e3);
    if (lane < 4) { const int id = lane == 0 ? ti[0] : lane == 1 ? ti[1] : lane == 2 ? ti[2] : ti[3]; const float w = (lane == 0 ? 1.0f : lane == 1 ? e1 : lane == 2 ? e2 : e3) * inv;
        topw[m * 4 + lane] = w;
        const unsigned rank = __hip_atomic_fetch_add(hist + id, 1u, __ATOMIC_RELAXED, __HIP_MEMORY_SCOPE_WORKGROUP); sel[sb + lane] = ((unsigned)id << 20) | rank; }
}
DI void router_top4(float lg, int e_own, int m, int sb, int lane, float* topw, LAS unsigned* hist, LAS unsigned* sel) {
    unsigned kA = router_key(lg, e_own);
    float tv[4]; int ti[4];
#pragma unroll
    for (int k = 0; k < 4; ++k) {
        const unsigned xA = wave_max_u32_dpp(kA);
        const int eA = 31 - (int)(xA & 31u);
        ti[k] = eA; tv[k] = __builtin_bit_cast(float, __builtin_amdgcn_readlane(__builtin_bit_cast(int, lg), 2 * eA));
        if (e_own == eA) kA = 0u; }
    router_emit(tv, ti, m, sb, lane, topw, hist, sel);
}
DI void ph_router(const PA& a, int l, LAS unsigned char* lds, int tid, int lane, int wave, int gw, int cslot) {
    unsigned char* ws = a.ws; const float* ADA = (const float*)(ws + WS_ADA);
    constexpr int WP = 1032;
    LAS bf16* WH = (LAS bf16*)lds; LAS bf16* WL = (LAS bf16*)(lds + 66048);
    LAS float* MOD = (LAS float*)(lds + 132096);
    LAS unsigned* hist = (LAS unsigned*)(lds + 140288);
    LAS unsigned* sel = hist + 64;
    LAS float* LG = (LAS float*)(lds + 142592) + wave * 528;
    const float* wr = a.in[I_WR] + (size_t)l * 1024 * 32;
    {
        f32x4 wv[16];
#pragma unroll
        for (int q = 0; q < 16; ++q) wv[q] = *(const f32x4*)(wr + 4 * (tid + 512 * q));
#pragma unroll
        for (int q = 0; q < 16; ++q) { const int idx = 4 * (tid + 512 * q), k = idx >> 5, e = idx & 31;
#pragma unroll
            for (int c = 0; c < 4; ++c) { const float w = wv[q][c]; const bf16 hb = f2bf(w); WH[(e + c) * WP + k] = hb; WL[(e + c) * WP + k] = f2bf(w - bf2f(hb)); } } }
    if (tid < 32) hist[tid] = 0u;
    { const int bq = (int)blockIdx.x >> 6; const float* gain = a.in[I_NMOE] + l * 1024; const float* adb = ADA + (l * 4 + bq) * 6144;
        for (int idx = tid; idx < 1024; idx += 512) { MOD[idx] = gain[idx] * (1.0f + adb[4096 + idx]); MOD[1024 + idx] = adb[3072 + idx]; } }
    __syncthreads();
    const bf16* x1 = (const bf16*)(ws + WS_X1); bf16* H = (bf16*)(ws + WS_H); float* topw = (float*)(ws + WS_TOPW);
    const int e_own = lane >> 1; const float be = a.in[I_BR][l * 32 + e_own];
    {
        const int r = lane & 15, q = lane >> 4, m0 = gw * 16;
        const bf16* xrow = x1 + (size_t)(m0 + r) * 1024; bf16* hrow = H + (size_t)(m0 + r) * 1024;
#define RT_COL(kt_) (64 * ((kt_) >> 1) + 16 * q + 8 * ((kt_) & 1))
#define RT_XLOAD(dst_, g_) do { _Pragma("unroll") for (int i_ = 0; i_ < 8; ++i_) dst_[i_] = *(const u32x4*)(xrow + RT_COL(8 * (g_) + i_)); } while (0)
#define RT_SQ(src_) do { _Pragma("unroll") for (int i_ = 0; i_ < 8; ++i_) { float f_[8]; pg8::unpack8(src_[i_], f_); _Pragma("unroll") for (int j_ = 0; j_ < 8; ++j_) ss += f_[j_] * f_[j_]; } } while (0)
#define RT_PROC(src_, g_) do { _Pragma("unroll") for (int i = 0; i < 8; ++i) { const int col = RT_COL(8 * (g_) + i); \
                float f[8], hh[8], hf[8], lo[8]; pg8::unpack8(src_[i], f); \
                const f32x4 g0 = *(const LAS f32x4*)(MOD + col), g1 = *(const LAS f32x4*)(MOD + col + 4), s0 = *(const LAS f32x4*)(MOD + 1024 + col), s1 = *(const LAS f32x4*)(MOD + 1024 + col + 4); \
                _Pragma("unroll") for (int j = 0; j < 8; ++j) hh[j] = f[j] * rstd * (j < 4 ? g0[j & 3] : g1[j & 3]) + (j < 4 ? s0[j & 3] : s1[j & 3]); \
                const u32x4 hi = pg8::pack8(hh); pg8::unpack8(hi, hf); \
                _Pragma("unroll") for (int j = 0; j < 8; ++j) lo[j] = hh[j] - hf[j]; \
                const u32x4 lov = pg8::pack8(lo); \
                *(u32x4*)(hrow + col) = hi; \
                const bf16x8 ah = __builtin_bit_cast(bf16x8, hi), al = __builtin_bit_cast(bf16x8, lov); \
                const bf16x8 bh0 = *(const LAS bf16x8*)(WH + r * WP + col), bh1 = *(const LAS bf16x8*)(WH + (16 + r) * WP + col); \
                const bf16x8 bl0 = *(const LAS bf16x8*)(WL + r * WP + col), bl1 = *(const LAS bf16x8*)(WL + (16 + r) * WP + col); \
                acc0 = MFMA16(ah, bh0, acc0); acc0 = MFMA16(al, bh0, acc0); acc0 = MFMA16(ah, bl0, acc0); \
                acc1 = MFMA16(ah, bh1, acc1); acc1 = MFMA16(al, bh1, acc1); acc1 = MFMA16(ah, bl1, acc1); } } while (0)
        u32x4 xa[8], xb[8];
        float ss = 0.f;
#define SB_ __builtin_amdgcn_sched_barrier(0)
        RT_XLOAD(xa, 0); RT_XLOAD(xb, 1); SB_; RT_SQ(xa); SB_; RT_XLOAD(xa, 2); SB_; RT_SQ(xb); SB_; RT_XLOAD(xb, 3); SB_; RT_SQ(xa); SB_;
        RT_XLOAD(xa, 0);
        SB_; RT_SQ(xb); SB_;
        ss += SHX(ss, 16); ss += SHX(ss, 32);
        const float rstd = 1.0f / sqrtf(ss * (1.0f / 1024.0f) + 1e-6f);
        f32x4 acc0 = (f32x4){0.f, 0.f, 0.f, 0.f}, acc1 = acc0;
        RT_XLOAD(xb, 1); SB_; RT_PROC(xa, 0); SB_; RT_XLOAD(xa, 2); SB_; RT_PROC(xb, 1); SB_; RT_XLOAD(xb, 3); SB_; RT_PROC(xa, 2); SB_; RT_PROC(xb, 3); SB_;
#undef SB_
#undef RT_XLOAD
#undef RT_SQ
#undef RT_PROC
#undef RT_COL
#pragma unroll
        for (int reg = 0; reg < 4; ++reg) { LG[(4 * q + reg) * 33 + r] = acc0[reg]; LG[(4 * q + reg) * 33 + 16 + r] = acc1[reg]; }
        LDS_WAIT();
#pragma nounroll
        for (int t = 0; t < 16; ++t) { float lg = LG[t * 33 + e_own] + be; lg = (lg == lg) ? fminf(fmaxf(lg, -1.0e30f), 1.0e30f) : 0.f;
            router_top4(lg, e_own, m0 + t, (wave * 16 + t) * 4, lane, topw, hist, sel); }
    }
    __syncthreads();
    if (tid < 32) { unsigned* cnt = (unsigned*)(ws + WS_CTL) + CW_CNT + 64 * cslot; const unsigned hv = hist[tid]; hist[32 + tid] = hv ? __hip_atomic_fetch_add(cnt + tid, hv, __ATOMIC_RELAXED, __HIP_MEMORY_SCOPE_AGENT) : 0u; }
    __syncthreads();
    { const unsigned v = sel[tid], e = v >> 20, widx = hist[32 + e] + (v & 0xFFFFFu); const int m = blockIdx.x * 128 + (tid >> 2);
        ((unsigned*)(ws + WS_TRAW))[m * 4 + (tid & 3)] = (e << 20) | widx; ((int*)(ws + WS_STOK))[e * M + widx] = m; }
    __syncthreads();
}

DI int build_expert_table(const PA& a, int l, LAS unsigned char* lds, int tid, int nct) {
    LAS int* tab = (LAS int*)(lds + TAB_OFF);
    {
        const unsigned* cnt = (const unsigned*)(a.ws + WS_CTL) + CW_CNT + 64 * l; int nb = 0, e0 = NE - 1, e1 = NE - 1; bool f0 = false, f1 = false;
        if (tid < NE) tab[672 + tid] = (int)cnt[tid];
        __syncthreads();
#pragma nounroll
        for (int e = 0; e < NE; ++e) { const int ce = tab[672 + e]; if (tid == e) tab[640 + e] = nb; nb += (ce + 255) >> 8; if (!f0 && tid < nb) { e0 = e; f0 = true; } if (!f1 && tid + 512 < nb) { e1 = e; f1 = true; } }
        tab[16 + tid] = e0; if (tid + 512 < 16 + 560) tab[16 + 512 + tid] = e1;
        if (tid == 0) tab[0] = nb; }
    __syncthreads();
    const int nblk = __builtin_amdgcn_readfirstlane(tab[0]);
    if (nct > 0) {
        { const int m = blockIdx.x * 128 + (tid >> 2); const unsigned v = ((const unsigned*)(a.ws + WS_TRAW))[m * 4 + (tid & 3)]; ((int*)(a.ws + WS_TSLOT))[m * 4 + (tid & 3)] = tab[640 + (v >> 20)] * 256 + (int)(v & 0xFFFFFu); }
        LAS int* rowt = (LAS int*)(lds + ROWT_OFF); const int* list = (const int*)(a.ws + WS_STOK);
        int tokv[9];
#pragma unroll
        for (int ii = 0; ii < 9; ++ii) { const int i = 2 * ii + (tid >> 8); int ct; const int blk = pg8::ExpertOrder<8>::unit_blk(i, (int)gridDim.x, (int)blockIdx.x, ct); tokv[ii] = 0;
            if (blk < nblk) { const int e = tab[16 + blk], w = (blk - tab[640 + e]) * 256 + (tid & 255); if (w < tab[672 + e]) tokv[ii] = list[e * M + w]; } }
#pragma unroll
        for (int ii = 0; ii < 9; ++ii) { const int i = 2 * ii + (tid >> 8); int ct; const int blk = pg8::ExpertOrder<8>::unit_blk(i, (int)gridDim.x, (int)blockIdx.x, ct);
            if (blk < nblk && i < 17) rowt[i * 256 + (tid & 255)] = tokv[ii]; }
        __syncthreads(); }
    return nblk;
}

#define LAUNDER() int tid = tid0; asm volatile("" : "+v"(tid)); tid &= 511; const int lane = tid & 63; (void)lane; int z_; asm volatile("s_mov_b32 %0, 0" : "=s"(z_)); const int gw = gw0 + z_; (void)gw; \
    unsigned char* ws = args.ws + z_; (void)ws; PA A; A.in = args.in + z_; A.out = args.out + z_; A.ws = ws; \
    bf16* const COLS = (bf16*)(ws + WS_COLS); bf16* const Hb = (bf16*)(ws + WS_H); const float* const ADA = (const float*)(ws + WS_ADA); (void)COLS; (void)Hb; (void)ADA
#ifndef PHMASK
#define PHMASK 0xFFFFu
#endif
#define IN(k) (lo <= (k) && (k) < hi)
#define EN(j) (((PHMASK) >> (j)) & 1u)
#ifndef REPMASK
#define REPMASK 0u
#endif
#define REP(j) (((REPMASK) >> (j)) & 1u)
#ifndef REPSUB
#define REPSUB 0u
#endif
#define RS(j) (1 + (int)(((REPSUB) >> (j)) & 1u))
#define SEAM(k) do { if (IN(k) && IN((k) + 1)) { XcdBarrier b2_ = bar; b2_.x = (unsigned)__builtin_amdgcn_readfirstlane((int)b2_.x); asm volatile("" : "+s"(b2_.x)); xcd_barrier(b2_); } } while (0)
#ifndef GEMM1_STAGGER
#define GEMM1_STAGGER 0
#endif
template <int L> DI void layer_body(const Args& args, LAS unsigned char* lds, const XcdBarrier& bar, const int tid0, const int wave, const int G, const int gw0, const int NGW, const int lo, const int hi) {
    constexpr int l = L; constexpr int pb = 1 + 13 * l;
        if (EN(0) && IN(pb + 0)) { LAUNDER(); if constexpr (L > 0) { ph_convert(A, l, lds, tid, lane, wave, gw, NGW); ph_norm(A, l, 1, lane, gw); } else ph_norm(A, l, 0, lane, gw); }
        if (REP(0) && IN(pb + 0)) { LAUNDER(); if constexpr (L > 0) { ph_convert(A, l, lds, tid, lane, wave, gw, NGW); ph_norm(A, l, 1, lane, gw); } else ph_norm(A, l, 0, lane, gw); }
        SEAM(pb + 0);
        if (EN(1) && IN(pb + 1)) { LAUNDER(); pg8::Gemm g{Hb, (const bf16*)(ws + WS_WIN), M, NIN, D}; pg8::StaticOrder So; So.init(M, NIN, G, (int)blockIdx.x);
#if GEMM1_STAGGER > 0
            if (blockIdx.x >= 128) {
#pragma nounroll
                for (int sl = 0; sl < GEMM1_STAGGER; ++sl) __builtin_amdgcn_s_sleep(127); }
#endif
            pg8::EpiPlainBf16 E{COLS, NIN};
            pg8::gemm_phase<pg8::EpiPlainBf16, pg8::StaticOrder, true, true>(lds, g, So, E); }
        if (REP(1) && IN(pb + 1)) { LAUNDER(); pg8::Gemm g{Hb, (const bf16*)(ws + WS_WIN), M, NIN, D}; pg8::StaticOrder So; So.init(M, NIN, G, (int)blockIdx.x);
            pg8::EpiPlainBf16 E{COLS, NIN};
            pg8::gemm_phase<pg8::EpiPlainBf16, pg8::StaticOrder, true, true>(lds, g, So, E); }
        SEAM(pb + 1);
        if (EN(2) && IN(pb + 2)) { LAUNDER();
#ifdef PREP_SEPARATE
            for (int rs = 0; rs < RS(0); ++rs) lru_phase(A, l, lds, tid, lane, wave);
            for (int rs = 0; rs < RS(1); ++rs) for (int it = gw; it < 8192; it += NGW) vt_item(COLS, (bf16*)(ws + WS_VT), it, (LAS bf16*)(lds + wave * 16384), lane);
            for (int rs = 0; rs < RS(2); ++rs) rw_prep_wave(A, l, gw * 16, lane);
#else
            lru_phase(A, l, lds, tid, lane, wave, gw * 16);
            for (int rs = 0; rs < RS(1); ++rs) for (int it = gw; it < 8192; it += NGW) vt_item(COLS, (bf16*)(ws + WS_VT), it, (LAS bf16*)(lds + wave * 16384), lane);
#endif
        }
        if (REP(2) && IN(pb + 2)) { LAUNDER();
            lru_phase(A, l, lds, tid, lane, wave);
            for (int it = gw; it < 8192; it += NGW) vt_item(COLS, (bf16*)(ws + WS_VT), it, (LAS bf16*)(lds + wave * 16384), lane);
            rw_prep_wave(A, l, gw * 16, lane);
        }
        SEAM(pb + 2);
        if (EN(3) && IN(pb + 3)) { LAUNDER(); lru_carry(A, tid); pg8::Gemm g{(const bf16*)(ws + WS_AP), (const bf16*)(ws + WS_LORAB), M, 3072, 256}; pg8::StaticOrder So; So.init(M, 3072, G, (int)blockIdx.x);
            pg8::EpiLora E{(bf16*)(ws + WS_OM), (bf16*)(ws + WS_BB), (bf16*)(ws + WS_KP), (const bf16*)(ws + WS_KK), (bf16*)(ws + WS_G), A.in[I_W0] + l * 1024, A.in[I_A0] + l * 1024, A.in[I_KA] + l * 1024};
            pg8::gemm_phase<pg8::EpiLora, pg8::StaticOrder, true, true>(lds, g, So, E); }
        if (REP(3) && IN(pb + 3)) { LAUNDER(); lru_carry(A, tid); pg8::Gemm g{(const bf16*)(ws + WS_AP), (const bf16*)(ws + WS_LORAB), M, 3072, 256}; pg8::StaticOrder So; So.init(M, 3072, G, (int)blockIdx.x);
            pg8::EpiLora E{(bf16*)(ws + WS_OM), (bf16*)(ws + WS_BB), (bf16*)(ws + WS_KP), (const bf16*)(ws + WS_KK), (bf16*)(ws + WS_G), A.in[I_W0] + l * 1024, A.in[I_A0] + l * 1024, A.in[I_KA] + l * 1024};
            pg8::gemm_phase<pg8::EpiLora, pg8::StaticOrder, true, true>(lds, g, So, E); }
        SEAM(pb + 3);
        if (EN(4) && IN(pb + 4)) { LAUNDER();
#ifdef LRU_FIN_SEPARATE
            for (int rs = 0; rs < RS(3); ++rs) { _Pragma("unroll 2") for (int i = 0; i < 16; ++i) lru_finish_row(A, gw * 16 + i, lane); }
#endif
            { u32x4 rin[6], rnx[6]; rw1_load(A, (int)blockIdx.x >> 7, (int)blockIdx.x & 127, lane, wave, rin);
              for (int u = blockIdx.x; u < 8192; u += G) { const int un = u + G; rw1_unit(A, l, u >> 7, u & 127, lds, tid, lane, wave, rin, un < 8192, un >> 7, un & 127, rnx, (u >> 8) < 24 ? ((int)blockIdx.x * 8 + wave) * 24 + (u >> 8) : -1,
#ifdef LRU_FIN_SEPARATE
                    -1, 0);
#else
                    gw * 16 + (u >> 9), (u >> 8) & 1);
#endif
#pragma unroll
                  for (int q = 0; q < 6; ++q) rin[q] = rnx[q]; } }
        }
        if (REP(4) && IN(pb + 4)) { LAUNDER();
            { u32x4 rin[6], rnx[6]; rw1_load(A, (int)blockIdx.x >> 7, (int)blockIdx.x & 127, lane, wave, rin);
              for (int u = blockIdx.x; u < 8192; u += G) { const int un = u + G; rw1_unit(A, l, u >> 7, u & 127, lds, tid, lane, wave, rin, un < 8192, un >> 7, un & 127, rnx, -1, -1, 0, true);
#pragma unroll
                  for (int q = 0; q < 6; ++q) rin[q] = rnx[q]; } }
        }
        SEAM(pb + 4);
        if (EN(5) && IN(pb + 5)) { LAUNDER();
            if (wave == 0) {
#ifdef RW2_PRIO
                __builtin_amdgcn_s_setprio(RW2_PRIO);
#endif
                for (int rs = 0; rs < RS(5); ++rs) rw2_chain(A, (int)blockIdx.x >> 2, (int)blockIdx.x & 3, lds, lane);
#ifdef RW2_PRIO
                __builtin_amdgcn_s_setprio(0);
#endif
            }
#ifdef ATT_SKIP_W4
            else { const int aw = wave < 4 ? wave - 1 : wave - 2;
              if (wave != 4) for (int rs = 0; rs < RS(4); ++rs) for (int sk = aw; sk < 32; sk += 6) { const int it = (((int)blockIdx.x >> 3) << 8) + (((int)blockIdx.x & 7) << 5) + sk;
                attn_strip(COLS, (const bf16*)(ws + WS_VT), (bf16*)(ws + WS_YB), it, lane, lds + RW2_RING_END + aw * ATT_LDS); } }
#else
            else { if (wave <= 6) for (int rs = 0; rs < RS(4); ++rs) for (int sk = wave - 1; sk < 32; sk += 6) { const int it = (((int)blockIdx.x >> 3) << 8) + (((int)blockIdx.x & 7) << 5) + sk;
                attn_strip(COLS, (const bf16*)(ws + WS_VT), (bf16*)(ws + WS_YB), it, lane, lds + RW2_RING_END + (wave - 1) * ATT_LDS); } }
#endif
        }
        if (REP(5) && IN(pb + 5)) { LAUNDER();
            if (wave == 0) rw2_chain(A, (int)blockIdx.x >> 2, (int)blockIdx.x & 3, lds, lane);
            else if (wave <= 6) for (int sk = wave - 1; sk < 32; sk += 6) { const int it = (((int)blockIdx.x >> 3) << 8) + (((int)blockIdx.x & 7) << 5) + sk;
                attn_strip(COLS, (const bf16*)(ws + WS_VT), (bf16*)(ws + WS_YB), it, lane, lds + RW2_RING_END + (wave - 1) * ATT_LDS); }
        }
        SEAM(pb + 5);
        if (EN(12) && IN(pb + 6)) { LAUNDER(); for (int it = gw; it < 16384; it += NGW) rw3_unit(A, l, it, lane, lds + wave * 18432); }
        if (REP(12) && IN(pb + 6)) { LAUNDER(); for (int it = gw; it < 16384; it += NGW) rw3_unit(A, l, it, lane, lds + wave * 18432); }
        SEAM(pb + 6);
        if (EN(6) && IN(pb + 7)) { LAUNDER(); pg8::StaticOrder So; So.init(M, D, G, (int)blockIdx.x); bf16* MG = (bf16*)(ws + WS_VT); const bf16* PT = (const bf16*)(ws + WS_PT);
            { pg8::Gemm g{(const bf16*)(ws + WS_YA), PT, M, D, D}; pg8::EpiMerge<0> E{MG, COLS}; pg8::gemm_phase<pg8::EpiMerge<0>, pg8::StaticOrder, true, true>(lds, g, So, E); }
            { pg8::Gemm g{(const bf16*)(ws + WS_YB), PT + (size_t)D * D, M, D, D}; pg8::EpiMerge<1> E{MG, COLS}; pg8::gemm_phase<pg8::EpiMerge<1>, pg8::StaticOrder, true, true>(lds, g, So, E); }
            { pg8::Gemm g{(const bf16*)(ws + WS_YC), PT + (size_t)2 * D * D, M, D, D}; pg8::EpiMerge<2> E{MG, COLS}; pg8::gemm_phase<pg8::EpiMerge<2>, pg8::StaticOrder, true, true>(lds, g, So, E); } }
        if (REP(6) && IN(pb + 7)) { LAUNDER(); pg8::StaticOrder So; So.init(M, D, G, (int)blockIdx.x); bf16* MG = (bf16*)(ws + WS_VT); const bf16* PT = (const bf16*)(ws + WS_PT);
            { pg8::Gemm g{(const bf16*)(ws + WS_YA), PT, M, D, D}; pg8::EpiMerge<0> E{MG, COLS}; pg8::gemm_phase<pg8::EpiMerge<0>, pg8::StaticOrder, true, true>(lds, g, So, E); }
            { pg8::Gemm g{(const bf16*)(ws + WS_YB), PT + (size_t)D * D, M, D, D}; pg8::EpiMerge<1> E{MG, COLS}; pg8::gemm_phase<pg8::EpiMerge<1>, pg8::StaticOrder, true, true>(lds, g, So, E); }
            { pg8::Gemm g{(const bf16*)(ws + WS_YC), PT + (size_t)2 * D * D, M, D, D}; pg8::EpiMerge<2> E{MG, COLS}; pg8::gemm_phase<pg8::EpiMerge<2>, pg8::StaticOrder, true, true>(lds, g, So, E); } }
        SEAM(pb + 7);
        if (EN(7) && IN(pb + 8)) { LAUNDER(); pg8::Gemm g{(const bf16*)(ws + WS_VT), (const bf16*)(ws + WS_WOUT), M, D, D}; pg8::StaticOrder So; So.init(M, D, G, (int)blockIdx.x);
            pg8::EpiResid<(L > 0)> E{L == 0 ? (const void*)A.in[I_X] : (const void*)(ws + WS_X2), (bf16*)(ws + WS_X1), ADA + (size_t)l * 4 * 6144 + 2048};
            pg8::gemm_phase<pg8::EpiResid<(L > 0)>, pg8::StaticOrder, true, true>(lds, g, So, E); }
        if (REP(7) && IN(pb + 8)) { LAUNDER(); pg8::Gemm g{(const bf16*)(ws + WS_VT), (const bf16*)(ws + WS_WOUT), M, D, D}; pg8::StaticOrder So; So.init(M, D, G, (int)blockIdx.x);
            pg8::EpiResid<(L > 0)> E{L == 0 ? (const void*)A.in[I_X] : (const void*)(ws + WS_X2), (bf16*)(ws + WS_X1), ADA + (size_t)l * 4 * 6144 + 2048};
            pg8::gemm_phase<pg8::EpiResid<(L > 0)>, pg8::StaticOrder, true, true>(lds, g, So, E); }
        SEAM(pb + 8);
        if (EN(8) && IN(pb + 9)) { LAUNDER(); for (int rs = 0; rs < RS(6); ++rs) ph_router(A, l, lds, tid, lane, wave, gw, rs + 1 < RS(6) ? l + 2 : l); }
        if (REP(8) && IN(pb + 9)) { LAUNDER(); for (int rs = 0; rs < RS(6); ++rs) ph_router(A, l, lds, tid, lane, wave, gw, rs + 1 < RS(6) ? l + 2 : l); }
        SEAM(pb + 9);
        if (EN(10) && IN(pb + 11)) { LAUNDER(); const int nblk = build_expert_table(A, l, lds, tid, 8);
            pg8::Gemm g{Hb, (const bf16*)(ws + WS_WGU), nblk * 256, NE * 2048, D};
            pg8::ExpertOrder<8> So{nblk, G, (int)blockIdx.x, (const LAS int*)(lds + TAB_OFF) + 16, (const LAS int*)(lds + ROWT_OFF)};
            pg8::EpiSwiglu E{(bf16*)(ws + WS_ACT), A.in[I_BGU] + (size_t)l * NE * 2048};
            pg8::gemm_phase<pg8::EpiSwiglu, pg8::ExpertOrder<8>, true, true, true>(lds, g, So, E); }
        if (REP(10) && IN(pb + 11)) { LAUNDER(); const int nblk = build_expert_table(A, l, lds, tid, 8);
            pg8::Gemm g{Hb, (const bf16*)(ws + WS_WGU), nblk * 256, NE * 2048, D};
            pg8::ExpertOrder<8> So{nblk, G, (int)blockIdx.x, (const LAS int*)(lds + TAB_OFF) + 16, (const LAS int*)(lds + ROWT_OFF)};
            pg8::EpiSwiglu E{(bf16*)(ws + WS_ACT), A.in[I_BGU] + (size_t)l * NE * 2048};
            pg8::gemm_phase<pg8::EpiSwiglu, pg8::ExpertOrder<8>, true, true, true>(lds, g, So, E); }
        SEAM(pb + 11);
        if (EN(11) && IN(pb + 12)) { LAUNDER(); const int nblk = build_expert_table(A, l, lds, tid, 0);
            pg8::Gemm g{(const bf16*)(ws + WS_ACT), (const bf16*)(ws + WS_WD), nblk * 256, NE * 1024, D};
            pg8::ExpertOrder<4> So{nblk, G, (int)blockIdx.x, (const LAS int*)(lds + TAB_OFF) + 16, nullptr};
            pg8::EpiDown E{(bf16*)(ws + WS_YBUF), A.in[I_BDN] + (size_t)l * NE * 1024};
            pg8::gemm_phase<pg8::EpiDown, pg8::ExpertOrder<4>, true, true>(lds, g, So, E); }
        if (REP(11) && IN(pb + 12)) { LAUNDER(); const int nblk = build_expert_table(A, l, lds, tid, 0);
            pg8::Gemm g{(const bf16*)(ws + WS_ACT), (const bf16*)(ws + WS_WD), nblk * 256, NE * 1024, D};
            pg8::ExpertOrder<4> So{nblk, G, (int)blockIdx.x, (const LAS int*)(lds + TAB_OFF) + 16, nullptr};
            pg8::EpiDown E{(bf16*)(ws + WS_YBUF), A.in[I_BDN] + (size_t)l * NE * 1024};
            pg8::gemm_phase<pg8::EpiDown, pg8::ExpertOrder<4>, true, true>(lds, g, So, E); }
        SEAM(pb + 12);

}
__global__ void __launch_bounds__(512, 2) fwd(Args args) {
    extern __shared__ __attribute__((aligned(16))) unsigned char lds_raw[];
    LAS unsigned char* lds = (LAS unsigned char*)lds_raw;
    const int tid0 = threadIdx.x, wave = __builtin_amdgcn_readfirstlane(tid0 >> 6);
    const int G = gridDim.x, gw0 = blockIdx.x * 8 + wave, NGW = G * 8;
    volatile LAS unsigned* MISC = (volatile LAS unsigned*)(lds + MISC_OFF);
    if (tid0 < 64) MISC[tid0] = 0u;
    __syncthreads();
    unsigned* ctl = (unsigned*)(args.ws + WS_CTL);
    XcdBarrier bar; bar.bar = ctl + CW_BAR; bar.x = 0; bar.st = nullptr;
    if (!MK_PER_PHASE) bar = xcd_barrier_post(ctl + CW_BAR, MISC + 8);
#if MK_PER_PHASE
    const int lo = args.ph_lo, hi = args.ph_hi;
#else
    constexpr int lo = 0, hi = N_PHASES;
#endif


    if (IN(0)) { LAUNDER(); ph_ada(A, lds, tid, lane, gw, NGW); ph_convert(A, 0, lds, tid, lane, wave, gw, NGW); }
    SEAM(0);
#ifdef PROBE_BARS
    for (int pb_ = 0; pb_ < PROBE_BARS; ++pb_) { SEAM(0); }
#endif

    layer_body<0>(args, lds, bar, tid0, wave, G, gw0, NGW, lo, hi);
    layer_body<1>(args, lds, bar, tid0, wave, G, gw0, NGW, lo, hi);
    if (IN(27)) { LAUNDER(); ph_norm(A, NL - 1, 2, lane, gw); }
#undef IN
#undef SEAM
}

extern "C" void kernel_launch(void* const* d_in, const int* in_sizes, int n_in, void* d_out, int out_size, void* d_ws, size_t ws_size, hipStream_t stream) {
    static int ready = 0;
    if (ready == 0) {
        if (n_in != 36 || in_sizes[0] != M * D || out_size != M * D || ws_size < WS_END) {
            fprintf(stderr, "kernel_launch: built for 36 inputs, x/out of %d floats, >= %zu bytes of workspace; got n_in %d, in0 %d, out %d, ws %zu; nothing launched\n", M * D, (size_t)WS_END, n_in, n_in > 0 ? in_sizes[0] : -1, out_size, ws_size);
            ready = -1; return; }
        if (hipFuncSetAttribute((const void*)fwd, hipFuncAttributeMaxDynamicSharedMemorySize, LDS_BYTES) != hipSuccess) { fprintf(stderr, "kernel_launch: hipFuncSetAttribute failed\n"); ready = -1; return; }
        int per_cu = 0;
        if (hipOccupancyMaxActiveBlocksPerMultiprocessor(&per_cu, (const void*)fwd, 512, LDS_BYTES) != hipSuccess || per_cu < 1) fprintf(stderr, "kernel_launch: note: occupancy query reports %d workgroups per CU\n", per_cu);
        (void)hipGetLastError();
        ready = 1;
    }
    if (ready < 0) return;
    if (hipMemsetAsync((char*)d_ws + WS_CTL, 0, CTL_ZERO_BYTES, stream) != hipSuccess) { fprintf(stderr, "kernel_launch: memset failed\n"); return; }
    Args a{};
    for (int i = 0; i < 36; ++i) a.in[i] = (const float*)d_in[i];
    a.out = (float*)d_out; a.ws = (unsigned char*)d_ws; a.li = 0; a.pad = 0;
    const int grid = 256;
#if MK_PER_PHASE
    for (int p = 0; p < N_PHASES; ++p) { a.ph_lo = p; a.ph_hi = p + 1; hipLaunchKernelGGL(fwd, dim3(grid), dim3(512), LDS_BYTES, stream, a); }
#else
    a.ph_lo = 0; a.ph_hi = N_PHASES;
    hipLaunchKernelGGL(fwd, dim3(grid), dim3(512), LDS_BYTES, stream, a);
#endif
    const hipError_t le = hipPeekAtLastError();
    if (le != hipSuccess) fprintf(stderr, "kernel_launch: launch failed: %s\n", hipGetErrorName(le));
}
```
